# Optimizing an MI355X kernel written in HIP

```python
import math
import jax, jax.numpy as jnp
from jax import lax
import numpy as np

D_MODEL = 1024
BATCH = 2
SEQ = 8192
DEPTH = 4

HEAD_DIM = 64
N_HEADS_A = 6
DILATED_PATTERNS = ((128, 1), (512, 4), (2048, 16))
N_HEADS_B = 6
Q_LORA_RANK = 384
KV_LORA_RANK = 256
QK_NOPE_DIM = 64
QK_ROPE_DIM = 32
V_HEAD_DIM = 64
ROPE_BASE = 10000.0
MLA_Q_BLOCK = 128
N_HEADS_C = 4
GRID_W = 64
NA_ROWS = 8
NA_COLS = 16
NA_COL_BLOCK = 16
NA_COL_SPAN = 32

WIDTH_A = N_HEADS_A * HEAD_DIM
WIDTH_B = N_HEADS_B * V_HEAD_DIM
WIDTH_C = N_HEADS_C * HEAD_DIM
MIX_WIDTH = WIDTH_A + WIDTH_B + WIDTH_C
SPLIT_SIZES = (WIDTH_A, WIDTH_A, WIDTH_A, Q_LORA_RANK, KV_LORA_RANK, QK_ROPE_DIM, WIDTH_C, WIDTH_C, WIDTH_C)
IN_COLS = sum(SPLIT_SIZES)
D_FF = 2816
N_EXPERTS = 8
TOP_K = 2
D_FF_EXPERT = 3584
MOE_BLOCK = 128
RMS_EPS = 1e-6
NEG_INF = -1e30

kernel_name = "hybrid_dilated_mla_neighbourhood_moe_encoder"


def rms_norm(x, g):
    xf = x.astype(jnp.float32)
    y = xf * lax.rsqrt(jnp.mean(xf * xf, axis=-1, keepdims=True) + RMS_EPS)
    return (y * g.astype(jnp.float32)).astype(x.dtype)


def alibi_slopes(n_heads):
    return 2.0 ** (-8.0 * jnp.arange(1, n_heads + 1, dtype=jnp.float32) / n_heads)


def rope(x, pos):
    r = x.shape[-1]
    inv = ROPE_BASE ** (-jnp.arange(0, r, 2, dtype=jnp.float32) / r)
    ang = pos[:, None].astype(jnp.float32) * inv[None, :]
    cos, sin = jnp.cos(ang), jnp.sin(ang)
    x1 = x[..., : r // 2].astype(jnp.float32)
    x2 = x[..., r // 2:].astype(jnp.float32)
    return jnp.concatenate([x1 * cos - x2 * sin, x1 * sin + x2 * cos], axis=-1).astype(x.dtype)


def dilated_window_branch(q, k, v, dilation, half, slopes):
    B, H, S, hd = q.shape
    n = S // dilation
    nb = -(-n // half)
    npad = nb * half

    def split(a):
        return a.reshape(B, H, n, dilation, hd).transpose(0, 1, 3, 2, 4)

    qs = jnp.pad(split(q), ((0, 0),) * 3 + ((0, npad - n), (0, 0))).reshape(B, H, dilation, nb, half, hd)

    def band(a):
        ap = jnp.pad(split(a), ((0, 0),) * 3 + ((half, npad - n + half), (0, 0)))
        ap = ap.reshape(B, H, dilation, nb + 2, half, hd)
        return jnp.concatenate([ap[:, :, :, 0:nb], ap[:, :, :, 1:nb + 1], ap[:, :, :, 2:nb + 2]], axis=4)

    kb, vb = band(k), band(v)
    qpos = jnp.arange(nb)[:, None] * half + jnp.arange(half)[None, :]
    kpos = jnp.arange(nb)[:, None] * half - half + jnp.arange(3 * half)[None, :]
    rel = kpos[:, None, :] - qpos[:, :, None]
    valid = (jnp.abs(rel) <= half) & (kpos[:, None, :] >= 0) & (kpos[:, None, :] < n)
    dist = (jnp.abs(rel) * dilation).astype(jnp.float32)
    s = jnp.einsum('bhrnqd,bhrnkd->bhrnqk', qs, kb).astype(jnp.float32) * (hd ** -0.5)
    s = s - slopes[None, :, None, None, None, None] * dist
    s = jnp.where(valid, s, NEG_INF)
    m = jnp.max(s, axis=-1, keepdims=True)
    p = jnp.exp(s - m)
    l = jnp.sum(p, axis=-1, keepdims=True)
    o = jnp.einsum('bhrnqk,bhrnkd->bhrnqd', (p / l).astype(v.dtype), vb)

    def merge(a):
        xdim = a.shape[-1]
        a = a.reshape(B, H, dilation, npad, xdim)[:, :, :, :n]
        return a.transpose(0, 1, 3, 2, 4).reshape(B, H, S, xdim)

    return merge(o), merge(m)[..., 0], merge(l)[..., 0]


def dilated_attention(q, k, v):
    slopes = alibi_slopes(q.shape[1])
    outs, ms, ls = [], [], []
    for window, dilation in DILATED_PATTERNS:
        o, m, l = dilated_window_branch(q, k, v, dilation, (window // 2) // dilation, slopes)
        outs.append(o)
        ms.append(m)
        ls.append(l)
    m_all = jnp.stack(ms)
    l_all = jnp.stack(ls)
    w = l_all * jnp.exp(m_all - jnp.max(m_all, axis=0, keepdims=True))
    w = w / jnp.sum(w, axis=0, keepdims=True)
    return jnp.einsum('gbhs,gbhsd->bhsd', w.astype(q.dtype), jnp.stack(outs))


def mla_attention(c_q, c_kv, k_rope_raw, g_q, g_kv, w_uq, w_ukv):
    B, S, _ = c_q.shape
    H = N_HEADS_B
    q = jnp.einsum('bsr,rf->bsf', rms_norm(c_q, g_q), w_uq)
    q = q.reshape(B, S, H, QK_NOPE_DIM + QK_ROPE_DIM).transpose(0, 2, 1, 3)
    kv = jnp.einsum('bsr,rf->bsf', rms_norm(c_kv, g_kv), w_ukv)
    kv = kv.reshape(B, S, H, QK_NOPE_DIM + V_HEAD_DIM).transpose(0, 2, 1, 3)
    pos = jnp.arange(S)
    q_nope, q_rope = q[..., :QK_NOPE_DIM], rope(q[..., QK_NOPE_DIM:], pos)
    k_nope, v = kv[..., :QK_NOPE_DIM], kv[..., QK_NOPE_DIM:]
    k_rope = rope(k_rope_raw, pos)
    scale = (QK_NOPE_DIM + QK_ROPE_DIM) ** -0.5
    nq = S // MLA_Q_BLOCK

    def to_blocks(a):
        return a.reshape(B, H, nq, MLA_Q_BLOCK, a.shape[-1]).transpose(2, 0, 1, 3, 4)

    def block(args):
        qn, qr = args
        s = (jnp.einsum('bhqd,bhkd->bhqk', qn, k_nope)
             + jnp.einsum('bhqr,bkr->bhqk', qr, k_rope)).astype(jnp.float32) * scale
        p = jax.nn.softmax(s, axis=-1).astype(v.dtype)
        return jnp.einsum('bhqk,bhkd->bhqd', p, v)

    o = lax.map(block, (to_blocks(q_nope), to_blocks(q_rope)))
    return o.transpose(1, 2, 0, 3, 4).reshape(B, H, S, V_HEAD_DIM)


def neighbourhood_attention(q, k, v, rpb):
    B, H, S, hd = q.shape
    rows = S // GRID_W
    kr = min(NA_ROWS, rows)
    ncb = GRID_W // NA_COL_BLOCK
    r = jnp.arange(rows)
    row_start = jnp.clip(r - kr // 2, 0, rows - kr)
    key_rows = row_start[:, None] + jnp.arange(kr)[None, :]
    cb = jnp.arange(ncb) * NA_COL_BLOCK
    col_start = jnp.clip(cb - NA_COLS // 2, 0, GRID_W - NA_COL_SPAN)
    key_cols = col_start[:, None] + jnp.arange(NA_COL_SPAN)[None, :]
    flat = key_rows[:, None, :, None] * GRID_W + key_cols[None, :, None, :]
    kg = k[:, :, flat]
    vg = v[:, :, flat]
    qg = q.reshape(B, H, rows, ncb, NA_COL_BLOCK, hd)
    s = jnp.einsum('bhrjqd,bhrjakd->bhrjqak', qg, kg).astype(jnp.float32) * (hd ** -0.5)
    qcol = cb[:, None] + jnp.arange(NA_COL_BLOCK)[None, :]
    win_start = jnp.clip(qcol - NA_COLS // 2, 0, GRID_W - NA_COLS)
    col_ok = (key_cols[:, None, :] >= win_start[:, :, None]) & (key_cols[:, None, :] < win_start[:, :, None] + NA_COLS)
    drow = key_rows - r[:, None]
    dcol = jnp.clip(key_cols[:, None, :] - qcol[:, :, None], -(NA_COLS - 1), NA_COLS - 1)
    bias = rpb[:, drow[:, None, None, :, None] + (NA_ROWS - 1), dcol[None, :, :, None, :] + (NA_COLS - 1)]
    s = s + bias[None].astype(jnp.float32)
    s = jnp.where(col_ok[None, None, None, :, :, None, :], s, NEG_INF)
    shp = s.shape
    p = jax.nn.softmax(s.reshape(shp[:5] + (kr * NA_COL_SPAN,)), axis=-1).reshape(shp)
    o = jnp.einsum('bhrjqak,bhrjakd->bhrjqd', p.astype(v.dtype), vg)
    return o.reshape(B, H, S, hd)


def hybrid_mixer(h, w_in, g_q, g_kv, w_uq, w_ukv, rpb, g_out_a, g_out_b, g_out_c, w_o):
    B, S, _ = h.shape
    proj = jnp.einsum('bsd,df->bsf', h, w_in)
    bounds = np.cumsum(SPLIT_SIZES)[:-1].tolist()
    qa, ka, va, c_q, c_kv, k_rope, qc, kc, vc = jnp.split(proj, bounds, axis=-1)

    def heads(a, n_heads):
        return a.reshape(B, S, n_heads, HEAD_DIM).transpose(0, 2, 1, 3)

    def flat(o):
        return o.transpose(0, 2, 1, 3).reshape(B, S, -1)

    out_a = dilated_attention(heads(qa, N_HEADS_A), heads(ka, N_HEADS_A), heads(va, N_HEADS_A))
    out_b = mla_attention(c_q, c_kv, k_rope, g_q, g_kv, w_uq, w_ukv)
    out_c = neighbourhood_attention(heads(qc, N_HEADS_C), heads(kc, N_HEADS_C), heads(vc, N_HEADS_C), rpb)
    y = jnp.concatenate([rms_norm(flat(out_a), g_out_a),
                         rms_norm(flat(out_b), g_out_b),
                         rms_norm(flat(out_c), g_out_c)], axis=-1)
    return jnp.einsum('bsf,fd->bsd', y, w_o)


def swiglu(h, w1, w3, w2):
    return (jax.nn.silu(h @ w1) * (h @ w3)) @ w2


def moe_swiglu(h, w_router, w1, w3, w2):
    B, S, D = h.shape
    x = h.reshape(-1, D)
    n_tok = x.shape[0]
    logits = jnp.einsum('nd,de->ne', x.astype(jnp.float32), w_router.astype(jnp.float32))
    top_logit, top_e = lax.top_k(logits, TOP_K)
    gates = jax.nn.softmax(top_logit, axis=-1)
    n_assign = n_tok * TOP_K
    flat_e = top_e.reshape(n_assign)
    order = jnp.argsort(flat_e)
    sorted_e = flat_e[order]
    sorted_tok = order // TOP_K
    sorted_gate = gates.reshape(n_assign)[order]
    counts = jnp.bincount(flat_e, length=N_EXPERTS)
    padded = (counts + MOE_BLOCK - 1) // MOE_BLOCK * MOE_BLOCK
    start = jnp.cumsum(counts) - counts
    padded_end = jnp.cumsum(padded)
    padded_start = padded_end - padded
    dest = padded_start[sorted_e] + jnp.arange(n_assign) - start[sorted_e]
    n_blocks = -(-(n_assign + N_EXPERTS * (MOE_BLOCK - 1)) // MOE_BLOCK)
    n_rows = n_blocks * MOE_BLOCK
    row_tok = jnp.zeros((n_rows,), jnp.int32).at[dest].set(sorted_tok.astype(jnp.int32))
    block_e = jnp.minimum(jnp.searchsorted(padded_end, jnp.arange(n_blocks) * MOE_BLOCK, side='right'), N_EXPERTS - 1)
    xb = x[row_tok].reshape(n_blocks, MOE_BLOCK, D)

    def expert_block(args):
        xi, e = args
        return swiglu(xi, w1[e], w3[e], w2[e])

    yb = lax.map(expert_block, (xb, block_e)).reshape(n_rows, D)
    y = jnp.zeros_like(x).at[sorted_tok].add(sorted_gate[:, None].astype(x.dtype) * yb[dest])
    return y.reshape(B, S, D)


def setup_inputs(seed: int = 0) -> dict:
    key = jax.random.key(seed)
    ks = jax.random.split(key, 24)
    f32 = jnp.float32
    n_dense = (DEPTH + 1) // 2
    n_moe = DEPTH // 2
    res = (2 * DEPTH) ** -0.5

    def normal(k, shape, fan_in, gain=1.0):
        return jax.random.normal(k, shape, f32) * (gain * fan_in ** -0.5)

    def norm_gain(k, shape):
        return 1.0 + 0.02 * jax.random.normal(k, shape, f32)

    return {
        "x": jax.random.normal(ks[0], (BATCH, SEQ, D_MODEL), f32),
        "g_mix": norm_gain(ks[1], (DEPTH, D_MODEL)),
        "w_in": normal(ks[2], (DEPTH, D_MODEL, IN_COLS), D_MODEL),
        "g_q": norm_gain(ks[3], (DEPTH, Q_LORA_RANK)),
        "g_kv": norm_gain(ks[4], (DEPTH, KV_LORA_RANK)),
        "w_uq": normal(ks[5], (DEPTH, Q_LORA_RANK, N_HEADS_B * (QK_NOPE_DIM + QK_ROPE_DIM)), Q_LORA_RANK),
        "w_ukv": normal(ks[6], (DEPTH, KV_LORA_RANK, N_HEADS_B * (QK_NOPE_DIM + V_HEAD_DIM)), KV_LORA_RANK),
        "rpb": 0.1 * jax.random.normal(ks[7], (DEPTH, N_HEADS_C, 2 * NA_ROWS - 1, 2 * NA_COLS - 1), f32),
        "g_out_a": norm_gain(ks[8], (DEPTH, WIDTH_A)),
        "g_out_b": norm_gain(ks[9], (DEPTH, WIDTH_B)),
        "g_out_c": norm_gain(ks[10], (DEPTH, WIDTH_C)),
        "w_o": normal(ks[11], (DEPTH, MIX_WIDTH, D_MODEL), MIX_WIDTH, res),
        "g_ffn": norm_gain(ks[12], (DEPTH, D_MODEL)),
        "w1": normal(ks[13], (n_dense, D_MODEL, D_FF), D_MODEL),
        "w3": normal(ks[14], (n_dense, D_MODEL, D_FF), D_MODEL),
        "w2": normal(ks[15], (n_dense, D_FF, D_MODEL), D_FF, res),
        "w_router": normal(ks[16], (n_moe, D_MODEL, N_EXPERTS), D_MODEL),
        "e_w1": normal(ks[17], (n_moe, N_EXPERTS, D_MODEL, D_FF_EXPERT), D_MODEL),
        "e_w3": normal(ks[18], (n_moe, N_EXPERTS, D_MODEL, D_FF_EXPERT), D_MODEL),
        "e_w2": normal(ks[19], (n_moe, N_EXPERTS, D_FF_EXPERT, D_MODEL), D_FF_EXPERT, res),
        "g_final": norm_gain(ks[20], (D_MODEL,)),
    }


def reference(x, g_mix, w_in, g_q, g_kv, w_uq, w_ukv, rpb, g_out_a, g_out_b, g_out_c, w_o,
              g_ffn, w1, w3, w2, w_router, e_w1, e_w3, e_w2, g_final):
    for layer in range(DEPTH):
        h = rms_norm(x, g_mix[layer])
        x = x + hybrid_mixer(h, w_in[layer], g_q[layer], g_kv[layer], w_uq[layer], w_ukv[layer], rpb[layer],
                             g_out_a[layer], g_out_b[layer], g_out_c[layer], w_o[layer])
        h = rms_norm(x, g_ffn[layer])
        j = layer // 2
        if layer % 2 == 0:
            x = x + swiglu(h, w1[j], w3[j], w2[j])
        else:
            x = x + moe_swiglu(h, w_router[j], e_w1[j], e_w3[j], e_w2[j])
    return rms_norm(x, g_final)
```

```cpp
#include <hip/hip_runtime.h>
#include <cstdio>
#include <cstdint>

#ifndef DBG_NSUB
#define DBG_NSUB 8
#endif

#define GAS __attribute__((address_space(1)))
#define LAS __attribute__((address_space(3)))
typedef unsigned short bf16_t;
typedef short bf16x8 __attribute__((ext_vector_type(8)));
typedef short s16x4 __attribute__((ext_vector_type(4)));
typedef float f32x2 __attribute__((ext_vector_type(2)));
typedef float f32x4 __attribute__((ext_vector_type(4)));
typedef float f32x16 __attribute__((ext_vector_type(16)));
typedef unsigned u32x2 __attribute__((ext_vector_type(2)));
typedef unsigned u32x4 __attribute__((ext_vector_type(4)));
typedef int i32x4 __attribute__((ext_vector_type(4)));

constexpr int DM = 1024, SEQ = 8192, MTOK = 16384, DEPTH = 4;
constexpr int PJ = 2816;
constexpr int PC_QA = 0, PC_KA = 384, PC_VA = 768, PC_CQ = 1152, PC_CKV = 1536, PC_QC = 1792, PC_KC = 2048, PC_VC = 2304, PC_KR = 2560;
constexpr int IN_COLS = 2592, QLR = 384, KVLR = 256, QUP = 576, QUP_PAD = 768, KVUP = 768;
constexpr int DFF = 2816, DFFE = 3584, NEXP = 8;
constexpr int MOE_ROWS = 34816;
constexpr float RMS_EPS = 1e-6f;

constexpr size_t MiB = 1u << 20;
constexpr size_t WS_CTL = 0, CTL_ZERO_BYTES = 2 * MiB;
constexpr size_t WS_TOK = 1 * MiB;
constexpr size_t WS_RSQ = 320 * 1024, WS_RSKV = 384 * 1024;
constexpr size_t WS_RSTD = 256 * 1024;
constexpr size_t WS_WIN = 4 * MiB, WS_WUQ = 26 * MiB, WS_WUKV = 29 * MiB, WS_WO = 31 * MiB, WS_W13 = 39 * MiB, WS_W2 = 61 * MiB, WS_EW13 = 72 * MiB, WS_EW2 = 296 * MiB;
constexpr size_t WS_X = 408 * MiB, WS_XN = 472 * MiB;
constexpr size_t WS_PROJ = 504 * MiB, WS_YN = 504 * MiB  , WS_CQN = 592 * MiB, WS_CKVN = 604 * MiB, WS_KR = 612 * MiB,
                 WS_QB = 613 * MiB, WS_KVB = 637 * MiB, WS_OA = 661 * MiB  , WS_Y = 721 * MiB  , WS_ML = 729 * MiB  ;
constexpr size_t WS_H = 504 * MiB;
constexpr size_t WS_YB = 742 * MiB, WS_ASG = 878 * MiB, WS_GATE = 878 * MiB + 512 * 1024, WS_YP = 880 * MiB  , WS_END = 892 * MiB;
static_assert(WS_WIN + (size_t)4 * PJ * DM * 2 <= WS_WUQ && WS_WUQ + (size_t)4 * QUP_PAD * QLR * 2 <= WS_WUKV && WS_WUKV + (size_t)4 * KVUP * KVLR * 2 <= WS_WO, "ws map 1");
static_assert(WS_WO + (size_t)4 * DM * DM * 2 <= WS_W13 && WS_W13 + (size_t)2 * 2 * DFF * DM * 2 <= WS_W2 && WS_W2 + (size_t)2 * DM * DFF * 2 <= WS_EW13, "ws map 2");
static_assert(WS_EW13 + (size_t)16 * 2 * DFFE * DM * 2 <= WS_EW2 && WS_EW2 + (size_t)16 * DM * DFFE * 2 <= WS_X && WS_X + (size_t)MTOK * DM * 4 <= WS_XN && WS_XN + (size_t)MTOK * DM * 2 <= WS_PROJ, "ws map 3");
static_assert(WS_PROJ + (size_t)MTOK * PJ * 2 <= WS_CQN && WS_CQN + (size_t)MTOK * QLR * 2 <= WS_CKVN && WS_CKVN + (size_t)MTOK * KVLR * 2 <= WS_KR && WS_KR + (size_t)MTOK * 32 * 2 <= WS_QB, "ws map 4");
static_assert(WS_QB + (size_t)MTOK * 768 * 2 <= WS_KVB && WS_KVB + (size_t)MTOK * 768 * 2 <= WS_OA && WS_OA + (size_t)5 * MTOK * 384 * 2 <= WS_Y && WS_Y + (size_t)MTOK * 256 * 2 <= WS_ML && WS_ML + (size_t)5 * MTOK * 8 * 8 <= WS_YB, "ws map 5");
static_assert(WS_H + (size_t)MOE_ROWS * DFFE * 2 <= WS_YB && WS_YB + (size_t)MOE_ROWS * DM * 4 <= WS_ASG && WS_GATE + (size_t)MTOK * 8 <= WS_END, "ws map 6");
constexpr int CW_TMO = 0, CW_BAR = 4096, CW_CUR = 8192  ;

#define LDS_WAIT() asm volatile("s_waitcnt lgkmcnt(0)" ::: "memory")
#define SBAR() __builtin_amdgcn_sched_barrier(0)
__device__ __forceinline__ unsigned cvt_pk_bf16(float lo, float hi) { unsigned r; asm volatile("v_cvt_pk_bf16_f32 %0, %1, %2" : "=v"(r) : "v"(lo), "v"(hi)); return r; }
__device__ __forceinline__ float bf2f(unsigned short b) { return __builtin_bit_cast(float, (unsigned)b << 16); }
__device__ __forceinline__ float bflo(unsigned w) { return __builtin_bit_cast(float, w << 16); }
__device__ __forceinline__ float bfhi(unsigned w) { return __builtin_bit_cast(float, w & 0xffff0000u); }
__device__ __forceinline__ float wave_sum(float v) {
#pragma unroll
    for (int o = 1; o < 64; o <<= 1) v += __shfl_xor(v, o);
    return v;
}
__device__ __forceinline__ void rope_cs(int pos, int j, float& c, float& s) {
    const float inv = exp2f(-(float)j * 0.83048202372184058696f);
    const float ang = (float)pos * inv;
    const double rev = (double)ang * 0.15915494309189533577;
    const float fr = (float)(rev - floor(rev));
    s = __builtin_amdgcn_sinf(fr); c = __builtin_amdgcn_cosf(fr);
}

namespace pg8 {
constexpr int BM = 256, BK = 64, HALF = 128, HTB = HALF * BK * 2, STAGE_BYTES = 8 * HTB, NXCD = 8, WGM = 8;
__host__ __device__ __forceinline__ int lds_byte(int r, int c) { const int st = (r >> 4) * 2 + (c >> 5), rr = r & 15, cc = c & 31, ob = rr * 64 + cc * 2; return st * 1024 + (ob ^ (((ob >> 9) & 1) << 5)); }
__host__ __device__ __forceinline__ void stage_rc(int b, int& R, int& C) { const int st = b / 1024, sb = b % 1024, swz = sb ^ (((sb >> 9) & 1) << 5); R = (st >> 1) * 16 + swz / 64; C = (st & 1) * 32 + (swz % 64) / 2; }
__host__ __device__ __forceinline__ int perm32(int rho) { const int n = rho >> 4, i = rho & 15; return 8 * (i >> 2) + 4 * n + (i & 3); }

struct Unit { int pm, pn, pnb, ar0, kc; };
struct Gemm { const bf16_t* A; const bf16_t* Bt; int K; const int* rowtab; int ld; };

struct StaticOrder {
    int nM, nN, nwg, G, c;
    __device__ void init(int M, int N, int G_, int c_) { nM = M / BM; nN = N / BM; nwg = nM * nN; G = G_; c = c_; }
    __device__ bool next(int i, Unit& u) const {
        const long L = (long)i * G + c; if (L >= nwg) return false;
        int wgid = (int)L; { const int q = nwg / NXCD, r = nwg % NXCD, xcd = wgid % NXCD, off = wgid / NXCD; wgid = (xcd < r ? xcd * (q + 1) : r * (q + 1) + (xcd - r) * q) + off; }
        const int nig = WGM * nN, gid = wgid / nig, fm = gid * WGM, gsz = (nM - fm) < WGM ? (nM - fm) : WGM;
        u.pm = fm + ((wgid % nig) % gsz); u.pn = (wgid % nig) / gsz; u.pnb = u.pn; u.ar0 = 0; u.kc = 0; return true;
    }
};
struct MoeOrder {
    StaticOrder so; int sb[9]; int rb0;
    __device__ void init(const LAS int* cnt, int N, int G_, int c_) {
        int s = 0;
#pragma unroll
        for (int e = 0; e < 8; ++e) { sb[e] = s; s += (cnt[e] + 255) >> 8; }
        sb[8] = s; so.nM = s; so.nN = N / BM; so.nwg = s * so.nN; so.G = G_; so.c = c_; rb0 = 0;
    }
    __device__ bool next(int i, Unit& u) const {
        if (!so.next(i, u)) return false;
        u.pm += rb0;
        int e = 0;
#pragma unroll
        for (int j = 1; j < 8; ++j) e += (u.pm >= sb[j]) ? 1 : 0;
        int sbe = sb[0];
#pragma unroll
        for (int j = 1; j < 8; ++j) sbe = (e == j) ? sb[j] : sbe;
        u.pnb = e * so.nN + u.pn; u.ar0 = e * 16384 + (u.pm - sbe) * 256; return true;
    }
    __device__ void skip_rows(int pm0) { so.nM -= pm0; so.nwg = so.nM * so.nN; rb0 = pm0; }
};
struct MoeTailOrder {
    MoeOrder mo; int nsub_;
    __device__ void init(const LAS int* cnt, int N, int G_, int c_, int pm0) { mo.init(cnt, N, G_, c_); nsub_ = pm0 * 16; }
    __device__ bool next(int i, Unit& u) const {
        const int idx = i * mo.so.G + mo.so.c; if (idx >= nsub_) return false;
        const int t = idx >> 2; u.pm = t >> 2; u.pn = t & 3; u.kc = idx & 3;
        int e = 0;
#pragma unroll
        for (int j = 1; j < 8; ++j) e += (u.pm >= mo.sb[j]) ? 1 : 0;
        u.pnb = e * mo.so.nN + u.pn; u.ar0 = 0; return true;
    }
};

struct EpiBf16 {
    static constexpr bool PERM = true, SCALE = false;
    bf16_t* O; int ldc;
    __device__ __forceinline__ void operator()(const f32x4 (&acc)[2][2][4][2], const Unit& u, int wr, int wc, int fr, int fq) const {
        const int row0 = u.pm * BM + wr * 64 + fr, col0 = u.pn * BM + wc * 32 + 8 * fq;
#pragma unroll
        for (int ai = 0; ai < 2; ++ai)
#pragma unroll
            for (int m = 0; m < 4; ++m) { bf16_t* rowp = O + (size_t)(row0 + ai * HALF + m * 16) * ldc + col0;
#pragma unroll
                for (int bj = 0; bj < 2; ++bj) { const f32x4 v0 = acc[ai][bj][m][0], v1 = acc[ai][bj][m][1];
                    u32x4 w; w.x = cvt_pk_bf16(v0[0], v0[1]); w.y = cvt_pk_bf16(v0[2], v0[3]); w.z = cvt_pk_bf16(v1[0], v1[1]); w.w = cvt_pk_bf16(v1[2], v1[3]);
                    *(u32x4*)(rowp + bj * HALF) = w; } }
    }
};
struct EpiBf16S {
    static constexpr bool PERM = true, SCALE = true;
    bf16_t* O; int ldc; const float* rs; float* SSL; int ncols;
    __device__ __forceinline__ void pre(const Unit& u, int wr, int fr, float (&rsv)[8]) const {
#pragma unroll
        for (int i = 0; i < 8; ++i) rsv[i] = rs[u.pm * BM + wr * 64 + fr + (i >> 2) * HALF + (i & 3) * 16]; }
    __device__ __forceinline__ void operator()(const f32x4 (&acc)[2][2][4][2], const Unit& u, int wr, int wc, int fr, int fq, const float (&rsv)[8]) const {
        const int row0 = u.pm * BM + wr * 64 + fr, col0 = u.pn * BM + wc * 32 + 8 * fq;
        const bool lat = SSL != nullptr && u.pn >= 4 && u.pn <= 6;
#pragma unroll
        for (int ai = 0; ai < 2; ++ai)
#pragma unroll
            for (int m = 0; m < 4; ++m) { const int row = row0 + ai * HALF + m * 16; bf16_t* rowp = O + (size_t)row * ldc + col0; const float r = rsv[ai * 4 + m]; float ss = 0.f;
#pragma unroll
                for (int bj = 0; bj < 2; ++bj) { const f32x4 v0 = acc[ai][bj][m][0] * r, v1 = acc[ai][bj][m][1] * r;
                    if (bj == 1 || u.pn != 4) ss += ((v0[0] * v0[0] + v0[1] * v0[1]) + (v0[2] * v0[2] + v0[3] * v0[3])) + ((v1[0] * v1[0] + v1[1] * v1[1]) + (v1[2] * v1[2] + v1[3] * v1[3]));
                    u32x4 w; w.x = cvt_pk_bf16(v0[0], v0[1]); w.y = cvt_pk_bf16(v0[2], v0[3]); w.z = cvt_pk_bf16(v1[0], v1[1]); w.w = cvt_pk_bf16(v1[2], v1[3]);
                    if (col0 + bj * HALF < ncols) *(u32x4*)(rowp + bj * HALF) = w; }
                if (lat) { ss += __shfl_xor(ss, 16); ss += __shfl_xor(ss, 32);
                    if (fq == 0) SSL[(size_t)row * 16 + (u.pn - 4) * 4 + wc] = ss; } }
    }
};
struct EpiSwiGLU {
    static constexpr bool PERM = true, SCALE = false;
    bf16_t* O; int ldc;
    __device__ __forceinline__ void operator()(const f32x4 (&acc)[2][2][4][2], const Unit& u, int wr, int wc, int fr, int fq) const {
        const int row0 = u.pm * BM + wr * 64 + fr, col0 = u.pn * (BM / 2) + wc * 16 + 4 * fq;
#pragma unroll
        for (int ai = 0; ai < 2; ++ai)
#pragma unroll
            for (int m = 0; m < 4; ++m) { bf16_t* rowp = O + (size_t)(row0 + ai * HALF + m * 16) * ldc + col0;
#pragma unroll
                for (int bj = 0; bj < 2; ++bj) { const f32x4 a = acc[ai][bj][m][0], b = acc[ai][bj][m][1]; float h[4];
#pragma unroll
                    for (int i = 0; i < 4; ++i) h[i] = a[i] * __builtin_amdgcn_rcpf(1.0f + __builtin_amdgcn_exp2f(-1.4426950408889634f * a[i])) * b[i];
                    u32x2 w; w.x = cvt_pk_bf16(h[0], h[1]); w.y = cvt_pk_bf16(h[2], h[3]);
                    *(u32x2*)(rowp + bj * (HALF / 2)) = w; } }
    }
};
struct EpiSwiGLUS {
    static constexpr bool PERM = true, SCALE = true;
    bf16_t* O; int ldc; const float* rs;
    __device__ __forceinline__ void pre(const Unit& u, int wr, int fr, float (&rsv)[8]) const {
#pragma unroll
        for (int i = 0; i < 8; ++i) rsv[i] = rs[u.pm * BM + wr * 64 + fr + (i >> 2) * HALF + (i & 3) * 16]; }
    __device__ __forceinline__ void operator()(const f32x4 (&acc)[2][2][4][2], const Unit& u, int wr, int wc, int fr, int fq, const float (&rsv)[8]) const {
        const int row0 = u.pm * BM + wr * 64 + fr, col0 = u.pn * (BM / 2) + wc * 16 + 4 * fq;
#pragma unroll
        for (int ai = 0; ai < 2; ++ai)
#pragma unroll
            for (int m = 0; m < 4; ++m) { bf16_t* rowp = O + (size_t)(row0 + ai * HALF + m * 16) * ldc + col0; const float r = rsv[ai * 4 + m];
#pragma unroll
                for (int bj = 0; bj < 2; ++bj) { const f32x4 a = acc[ai][bj][m][0] * r, b = acc[ai][bj][m][1] * r; float h[4];
#pragma unroll
                    for (int i = 0; i < 4; ++i) h[i] = a[i] * __builtin_amdgcn_rcpf(1.0f + __builtin_amdgcn_exp2f(-1.4426950408889634f * a[i])) * b[i];
                    u32x2 w; w.x = cvt_pk_bf16(h[0], h[1]); w.y = cvt_pk_bf16(h[2], h[3]);
                    *(u32x2*)(rowp + bj * (HALF / 2)) = w; } }
    }
};
struct EpiResid {
    static constexpr bool PERM = false, SCALE = false;
    const float* src; float* out; int ldc;
    __device__ __forceinline__ void operator()(const f32x4 (&acc)[2][2][4][2], const Unit& u, int wr, int wc, int fr, int fq) const {
        const int row0 = u.pm * BM + wr * 64 + fr, col0 = u.pn * BM + wc * 32 + 4 * fq;
#pragma unroll
        for (int ai = 0; ai < 2; ++ai)
#pragma unroll
            for (int m = 0; m < 4; ++m) { const size_t off = (size_t)(row0 + ai * HALF + m * 16) * ldc + col0;
#pragma unroll
                for (int bj = 0; bj < 2; ++bj)
#pragma unroll
                    for (int n = 0; n < 2; ++n) { f32x4 v = acc[ai][bj][m][n]; if (src) v += *(const f32x4*)(src + off + bj * HALF + n * 16); *(f32x4*)(out + off + bj * HALF + n * 16) = v; } }
    }
};

struct EpiResidB {
    static constexpr bool PERM = true, SCALE = false;
    const float* src32; const bf16_t* src16; bf16_t* out; int ldc; float* SS;
    __device__ __forceinline__ void operator()(const f32x4 (&acc)[2][2][4][2], const Unit& u, int wr, int wc, int fr, int fq) const {
        const int row0 = u.pm * BM + wr * 64 + fr, col0 = u.pn * BM + wc * 32 + 8 * fq;
#pragma unroll
        for (int ai = 0; ai < 2; ++ai)
#pragma unroll
            for (int m = 0; m < 4; ++m) { const int row = row0 + ai * HALF + m * 16; const size_t off = (size_t)row * ldc + col0; float ss = 0.f;
#pragma unroll
                for (int bj = 0; bj < 2; ++bj) { f32x4 v0 = acc[ai][bj][m][0], v1 = acc[ai][bj][m][1];
                    if (src32) { v0 += *(const f32x4*)(src32 + off + bj * HALF); v1 += *(const f32x4*)(src32 + off + bj * HALF + 4); }
                    else { const u32x4 x = *(const u32x4*)(src16 + off + bj * HALF);
                        v0 += (f32x4){bflo(x.x), bfhi(x.x), bflo(x.y), bfhi(x.y)}; v1 += (f32x4){bflo(x.z), bfhi(x.z), bflo(x.w), bfhi(x.w)}; }
                    ss += ((v0[0] * v0[0] + v0[1] * v0[1]) + (v0[2] * v0[2] + v0[3] * v0[3])) + ((v1[0] * v1[0] + v1[1] * v1[1]) + (v1[2] * v1[2] + v1[3] * v1[3]));
                    u32x4 w; w.x = cvt_pk_bf16(v0[0], v0[1]); w.y = cvt_pk_bf16(v0[2], v0[3]); w.z = cvt_pk_bf16(v1[0], v1[1]); w.w = cvt_pk_bf16(v1[2], v1[3]);
                    *(u32x4*)(out + off + bj * HALF) = w; }
                if (SS) { ss += __shfl_xor(ss, 16); ss += __shfl_xor(ss, 32);
                    if (fq == 0) SS[(size_t)row * 16 + u.pn * 4 + wc] = ss; } }
    }
};
struct EpiQuarter {
    static constexpr bool PERM = false, SCALE = false;
    bf16_t* out0; bf16_t* outq; size_t qstride; int ldc;
    __device__ __forceinline__ void operator()(const f32x4 (&acc)[2][2][4][2], const Unit& u, int wr, int wc, int fr, int fq) const {
        const int row0 = u.pm * BM + wr * 64 + fr, col0 = u.pn * BM + wc * 32 + 4 * fq;
        bf16_t* out = u.kc == 0 ? out0 : outq + (size_t)(u.kc - 1) * qstride;
#pragma unroll
        for (int ai = 0; ai < 2; ++ai)
#pragma unroll
            for (int m = 0; m < 4; ++m) { const size_t off = (size_t)(row0 + ai * HALF + m * 16) * ldc + col0;
#pragma unroll
                for (int bj = 0; bj < 2; ++bj)
#pragma unroll
                    for (int n = 0; n < 2; ++n) { const f32x4 a = acc[ai][bj][m][n]; u32x2 w; w.x = cvt_pk_bf16(a.x, a.y); w.y = cvt_pk_bf16(a.z, a.w); *(u32x2*)(out + off + bj * HALF + n * 16) = w; } }
    }
};

template <class Epi, class Sched, bool ALIGN_EPI, bool GATHER, bool KSPLIT = false, bool APITCH = false>
__device__ __forceinline__ void gemm_phase(LAS unsigned char* lds, const Gemm g, const Sched& S, const Epi& E) {
    int tid = threadIdx.x; asm volatile("" : "+v"(tid));
    const int wid = __builtin_amdgcn_readfirstlane(tid >> 6), lane = tid & 63, wr = wid >> 2, wc = wid & 3, fr = lane & 15, fq = lane >> 4;
    const int K = g.K, nt = K / BK, LDA = (KSPLIT || APITCH) ? g.ld : K, LDB = KSPLIT ? g.ld : K;
    unsigned voffA[2], voffB[2]; unsigned CA2[2];
#pragma unroll
    for (int i = 0; i < 2; ++i) { int R, C; stage_rc(tid * 16 + i * 8192, R, C); const int Rb = Epi::PERM ? ((R & ~31) + perm32(R & 31)) : R;
        voffA[i] = (unsigned)(R * LDA + C) * 2u; voffB[i] = (unsigned)(Rb * LDB + C) * 2u; CA2[i] = (unsigned)C * 2u; }
    const size_t kstep = (size_t)(BK * 2);
    const size_t hstepA = (size_t)HALF * LDA * 2, hstepB = (size_t)HALF * LDB * 2;
    const size_t tstepA = 2 * hstepA, tstepB = 2 * hstepB;
    const unsigned ldsw = (unsigned)wid * 1024u;
    const int aoff = lds_byte(wr * 64 + fr, fq * 8), boff = lds_byte(wc * 32 + fr, fq * 8);
#define PG8_SA(b, h) (((b) * 2 + (h)) * HTB)
#define PG8_SB(b, h) ((4 + (b) * 2 + (h)) * HTB)
#define PG8_STAGE(bufoff, gbase, voff) do { _Pragma("unroll") for (int _i = 0; _i < 2; ++_i) \
        __builtin_amdgcn_global_load_lds((const unsigned*)((const char*)(gbase) + (voff)[_i]), (LAS unsigned*)(lds + (bufoff) + ldsw + _i * 8192), 16, 0, 0); } while (0)
#define PG8_LDA(dst, b, h) do { _Pragma("unroll") for (int m = 0; m < 4; ++m) _Pragma("unroll") for (int k = 0; k < 2; ++k) dst[m][k] = *(const LAS bf16x8*)(lds + PG8_SA(b, h) + aoff + m * 2048 + k * 1024); } while (0)
#define PG8_LDB(dst, b, h) do { _Pragma("unroll") for (int n = 0; n < 2; ++n) _Pragma("unroll") for (int k = 0; k < 2; ++k) dst[n][k] = *(const LAS bf16x8*)(lds + PG8_SB(b, h) + boff + n * 2048 + k * 1024); } while (0)
#define PG8_MMA(ai, bj, At, Bt) do { __builtin_amdgcn_s_setprio(1); _Pragma("unroll") for (int m = 0; m < 4; ++m) _Pragma("unroll") for (int n = 0; n < 2; ++n) _Pragma("unroll") for (int k = 0; k < 2; ++k) \
        acc[ai][bj][m][n] = __builtin_amdgcn_mfma_f32_16x16x32_bf16(Bt[n][k], At[m][k], acc[ai][bj][m][n], 0, 0, 0); __builtin_amdgcn_s_setprio(0); } while (0)
#define PG8_WAIT_V(n) asm volatile("s_waitcnt vmcnt(" #n ")" ::: "memory")
#define PG8_WAIT_L(n) asm volatile("s_waitcnt lgkmcnt(" #n ")" ::: "memory")
#define PG8_BAR __builtin_amdgcn_s_barrier()
#define PG8_STAGE_A(buf, h, p, usenext) do { if constexpr (GATHER) { const unsigned _t = (usenext) ? tkn[h] : tkc[h]; unsigned _v[2]; _v[0] = (_t & 0xffffu) * rowb + CA2[0]; _v[1] = (_t >> 16) * rowb + CA2[1]; PG8_STAGE(PG8_SA(buf, h), p, _v); } \
        else { PG8_STAGE(PG8_SA(buf, h), (p) + (h) * hstepA, voffA); } } while (0)
    Unit cur, nxt; int ui = 0;
    if (!S.next(0, cur)) return;
    f32x4 acc[2][2][4][2];
#pragma unroll
    for (int a = 0; a < 2; ++a)
#pragma unroll
        for (int b = 0; b < 2; ++b)
#pragma unroll
            for (int m = 0; m < 4; ++m)
#pragma unroll
                for (int n = 0; n < 2; ++n) acc[a][b][m][n] = (f32x4){0.f, 0.f, 0.f, 0.f};
    bf16x8 At[4][2], B0[2][2], B1[2][2];
    unsigned tkc[2], tkn[2];
    const unsigned rowb = (unsigned)LDA * 2u;
#define PG8_TOKS(dst, u_) do { int _R0, _R1, _C; stage_rc(tid * 16, _R0, _C); stage_rc(tid * 16 + 8192, _R1, _C); _Pragma("unroll") for (int h = 0; h < 2; ++h) dst[h] = (unsigned)g.rowtab[(u_).ar0 + h * HALF + _R0] | ((unsigned)g.rowtab[(u_).ar0 + h * HALF + _R1] << 16); } while (0)
    if constexpr (GATHER) {
        PG8_TOKS(tkc, cur); tkn[0] = 0u; tkn[1] = 0u;
        Unit n1; if (S.next(1, n1)) PG8_TOKS(tkn, n1);
    }
    const char* cA = GATHER ? (const char*)g.A : (const char*)g.A + (size_t)cur.pm * tstepA; const char* cB = (const char*)g.Bt + (size_t)cur.pnb * tstepB;
    if constexpr (KSPLIT) { cA += (size_t)cur.kc * K * 2; cB += (size_t)cur.kc * K * 2; }
    PG8_STAGE(PG8_SB(0, 0), cB, voffB); PG8_STAGE(PG8_SB(0, 1), cB + hstepB, voffB); PG8_STAGE_A(0, 0, cA, false); PG8_STAGE_A(0, 1, cA, false);
    if (wr == 1) PG8_BAR;
    PG8_WAIT_V(2); PG8_BAR;
    PG8_STAGE(PG8_SB(1, 0), cB + kstep, voffB); PG8_STAGE_A(1, 0, cA + kstep, false); PG8_STAGE(PG8_SB(1, 1), cB + hstepB + kstep, voffB);
    PG8_WAIT_V(6); PG8_BAR;
    float rsv[8];
    for (;;) {
        const bool has_next = S.next(ui + 1, nxt);
        if constexpr (Epi::SCALE) E.pre(cur, wr, fr, rsv);
        if constexpr (GATHER) {
            asm volatile("" : "+v"(tkn[0]), "+v"(tkn[1]));
        }
        const char* nA = GATHER ? cA : (has_next ? (const char*)g.A + (size_t)nxt.pm * tstepA : cA); const char* nB = has_next ? (const char*)g.Bt + (size_t)nxt.pnb * tstepB : cB;
        if constexpr (KSPLIT) { if (has_next) { nA += (size_t)nxt.kc * K * 2; nB += (size_t)nxt.kc * K * 2; } }
        for (int t = 0; t < nt; t += 2) {
            const bool last = (t == nt - 2);
            const bool un = last && has_next;
            const char* a1 = cA + (size_t)(t + 1) * kstep;
            const char* a2 = last ? nA : cA + (size_t)(t + 2) * kstep; const char* b2 = last ? nB : cB + (size_t)(t + 2) * kstep;
            const char* a3 = a2 + kstep; const char* b3 = b2 + kstep;
            PG8_LDB(B0, 0, 0); PG8_LDB(B1, 0, 1); SBAR(); PG8_LDA(At, 0, 0); PG8_STAGE_A(1, 1, a1, false);
            PG8_WAIT_V(8); PG8_WAIT_L(0); PG8_BAR; PG8_MMA(0, 0, At, B0); PG8_MMA(0, 1, At, B1); PG8_BAR; SBAR();
            PG8_LDA(At, 0, 1); PG8_STAGE(PG8_SB(0, 0), b2, voffB); PG8_STAGE(PG8_SB(0, 1), b2 + hstepB, voffB); PG8_STAGE_A(0, 0, a2, un);
            PG8_WAIT_V(8); PG8_WAIT_L(0); PG8_BAR; PG8_MMA(1, 0, At, B0); PG8_MMA(1, 1, At, B1); PG8_BAR; SBAR();
            PG8_LDB(B0, 1, 0); PG8_LDB(B1, 1, 1); SBAR(); PG8_LDA(At, 1, 0); PG8_STAGE_A(0, 1, a2, un);
            PG8_WAIT_V(8); PG8_WAIT_L(0); PG8_BAR; PG8_MMA(0, 0, At, B0); PG8_MMA(0, 1, At, B1); PG8_BAR; SBAR();
            PG8_LDA(At, 1, 1); PG8_STAGE(PG8_SB(1, 0), b3, voffB); PG8_STAGE(PG8_SB(1, 1), b3 + hstepB, voffB); PG8_STAGE_A(1, 0, a3, un);
            PG8_WAIT_V(8); PG8_WAIT_L(0); PG8_BAR; PG8_MMA(1, 0, At, B0); PG8_MMA(1, 1, At, B1); PG8_BAR; SBAR();
        }
        if constexpr (ALIGN_EPI) { if (wr == 0) PG8_BAR; }
        if constexpr (Epi::SCALE) E(acc, cur, wr, wc, fr, fq, rsv); else E(acc, cur, wr, wc, fr, fq);
        if (!has_next) break;
#pragma unroll
        for (int a = 0; a < 2; ++a)
#pragma unroll
            for (int b = 0; b < 2; ++b)
#pragma unroll
                for (int m = 0; m < 4; ++m)
#pragma unroll
                    for (int n = 0; n < 2; ++n) acc[a][b][m][n] = (f32x4){0.f, 0.f, 0.f, 0.f};
        cur = nxt; cA = nA; cB = nB; ++ui;
        if constexpr (GATHER) {
            tkc[0] = tkn[0]; tkc[1] = tkn[1];
            Unit n2; if (S.next(ui + 1, n2)) PG8_TOKS(tkn, n2);
        }
        if constexpr (ALIGN_EPI) { if (wr == 1) PG8_BAR; }
    }
    PG8_WAIT_V(0);
    if constexpr (!ALIGN_EPI) { if (wr == 0) PG8_BAR; }
    PG8_BAR;
#undef PG8_SA
#undef PG8_SB
#undef PG8_STAGE
#undef PG8_STAGE_A
#undef PG8_TOKS
#undef PG8_LDA
#undef PG8_LDB
#undef PG8_MMA
#undef PG8_WAIT_V
#undef PG8_WAIT_L
#undef PG8_BAR
}
}

namespace att {
constexpr int SHM_K = 64 * 256, SHM_V = 64 * 64 * 2;
constexpr int L_K = 0, L_V = 2 * SHM_K, L_WS = L_V + 2 * SHM_V, L_RPB = L_WS + 8 * 256, L_END = L_RPB + 2048;
#define KSWZ(row, colB) ((row) * 256 + ((colB) ^ (((row) & 15) << 4)))
__device__ __forceinline__ int crow(int r, int hi) { return (r & 3) + 8 * (r >> 2) + 4 * hi; }
__device__ __forceinline__ int v_st(int k, int c) { const int kk = (k & ~0xC) | ((k & 4) << 1) | ((k & 8) >> 1); return ((kk >> 3) * 2 + (c >> 5)) * 512 + ((kk & 7) * 32 + (c & 31)) * 2; }
__device__ __forceinline__ int v_rd_base(int lane) { return ((lane & 3) << 3) | (((lane >> 2) & 3) << 6) | (((lane >> 4) & 1) << 5) | (((lane >> 5) & 1) << 8); }
constexpr int v_rd_off(int d0, int ks, int half) { return d0 * 512 + ks * 2048 + half * 1024; }
template <int OFF> __device__ __forceinline__ s16x4 tr_read(int vb) { s16x4 r; asm volatile("ds_read_b64_tr_b16 %0, %1 offset:%2" : "=&v"(r) : "v"(vb), "i"(OFF) : "memory"); return r; }

__device__ __forceinline__ void partialSM(f32x16& p0, f32x16& p1, float& m_reg, float& mn, float& alpha, const float C, const float THRR) {
  float ma = fmaxf(fmaxf(p0[0], p0[1]), p0[2]), mb = fmaxf(fmaxf(p1[0], p1[1]), p1[2]);
#pragma unroll
  for (int r = 3; r < 15; r += 2) { ma = fmaxf(fmaxf(ma, p0[r]), p0[r + 1]); mb = fmaxf(fmaxf(mb, p1[r]), p1[r + 1]); }
  float pmax = fmaxf(fmaxf(ma, p0[15]), fmaxf(mb, p1[15]));
  if (__builtin_expect(__all(pmax - m_reg <= THRR), 1)) { mn = m_reg; alpha = 1.f; }
  else { { auto rr = __builtin_amdgcn_permlane32_swap(__float_as_uint(pmax), __float_as_uint(pmax), false, false);
           pmax = fmaxf(__uint_as_float(rr[0]), __uint_as_float(rr[1])); }
    mn = fmaxf(m_reg, pmax); alpha = __builtin_amdgcn_exp2f((m_reg - mn) * C); m_reg = mn; }
  const float mnC = -mn * C;
#pragma unroll
  for (int r = 0; r < 16; ++r) p0[r] = fmaf(p0[r], C, mnC);
#pragma unroll
  for (int r = 0; r < 16; ++r) p1[r] = fmaf(p1[r], C, mnC);
#pragma unroll
  for (int r = 0; r < 16; ++r) p0[r] = __builtin_amdgcn_exp2f(p0[r]);
}
__device__ __forceinline__ void finishSM(f32x16& p0, f32x16& p1, float alpha, float& l_reg, bf16x8& pa0, bf16x8& pa1, bf16x8& pa2, bf16x8& pa3) {
#pragma unroll
  for (int r = 0; r < 16; ++r) p1[r] = __builtin_amdgcn_exp2f(p1[r]);
  float s0 = p0[0], s1 = p0[8], s2 = p1[0], s3 = p1[8];
#pragma unroll
  for (int r = 1; r < 8; ++r) { s0 += p0[r]; s1 += p0[8 + r]; s2 += p1[r]; s3 += p1[8 + r]; }
  float ps = (s0 + s1) + (s2 + s3);
  { auto rr = __builtin_amdgcn_permlane32_swap(__float_as_uint(ps), __float_as_uint(ps), false, false);
    ps = __uint_as_float(rr[0]) + __uint_as_float(rr[1]); }
  l_reg = l_reg * alpha + ps;
#define PK4(P, BASE, OUT) do { unsigned a0 = cvt_pk_bf16(P[BASE + 0], P[BASE + 1]), a1 = cvt_pk_bf16(P[BASE + 2], P[BASE + 3]);   \
    unsigned b0 = cvt_pk_bf16(P[BASE + 4], P[BASE + 5]), b1 = cvt_pk_bf16(P[BASE + 6], P[BASE + 7]);                              \
    auto r0 = __builtin_amdgcn_permlane32_swap(a0, b0, false, false); auto r1 = __builtin_amdgcn_permlane32_swap(a1, b1, false, false); \
    u32x4 w = {r0[0], r1[0], r0[1], r1[1]}; OUT = __builtin_bit_cast(bf16x8, w); } while (0)
  PK4(p0, 0, pa0); PK4(p0, 8, pa1); PK4(p1, 0, pa2); PK4(p1, 8, pa3);
#undef PK4
}
__device__ __forceinline__ void maskedSM(f32x16& p0, f32x16& p1, unsigned vm0, unsigned vm1, float& m_reg, float& alpha, const float C, const float THRR) {
  float pmax = p0[0];
#pragma unroll
  for (int r = 1; r < 16; ++r) pmax = fmaxf(pmax, p0[r]);
#pragma unroll
  for (int r = 0; r < 16; ++r) pmax = fmaxf(pmax, p1[r]);
  { auto rr = __builtin_amdgcn_permlane32_swap(__float_as_uint(pmax), __float_as_uint(pmax), false, false);
    pmax = fmaxf(__uint_as_float(rr[0]), __uint_as_float(rr[1])); }
  float mn;
  if (__builtin_expect(__all(pmax - m_reg <= THRR), 1)) { mn = m_reg; alpha = 1.f; }
  else { mn = fmaxf(m_reg, pmax); alpha = __builtin_amdgcn_exp2f((m_reg - mn) * C); m_reg = mn; }
  const float mnC = -mn * C;
#pragma unroll
  for (int r = 0; r < 16; ++r) { const float e0 = __builtin_amdgcn_exp2f(fmaf(p0[r], C, mnC)), e1 = __builtin_amdgcn_exp2f(fmaf(p1[r], C, mnC));
    p0[r] = ((vm0 >> r) & 1u) ? e0 : 0.f; p1[r] = ((vm1 >> r) & 1u) ? e1 : 0.f; }
}
__device__ __forceinline__ void packSM(const f32x16& p0, const f32x16& p1, float alpha, float& l_reg, bf16x8& pa0, bf16x8& pa1, bf16x8& pa2, bf16x8& pa3) {
  float ps = 0;
#pragma unroll
  for (int r = 0; r < 16; ++r) ps += p0[r];
#pragma unroll
  for (int r = 0; r < 16; ++r) ps += p1[r];
  { auto rr = __builtin_amdgcn_permlane32_swap(__float_as_uint(ps), __float_as_uint(ps), false, false);
    ps = __uint_as_float(rr[0]) + __uint_as_float(rr[1]); }
  l_reg = l_reg * alpha + ps;
#define PK4(P, BASE, OUT) do { unsigned a0 = cvt_pk_bf16(P[BASE + 0], P[BASE + 1]), a1 = cvt_pk_bf16(P[BASE + 2], P[BASE + 3]);   \
    unsigned b0 = cvt_pk_bf16(P[BASE + 4], P[BASE + 5]), b1 = cvt_pk_bf16(P[BASE + 6], P[BASE + 7]);                              \
    auto r0 = __builtin_amdgcn_permlane32_swap(a0, b0, false, false); auto r1 = __builtin_amdgcn_permlane32_swap(a1, b1, false, false); \
    u32x4 w = {r0[0], r1[0], r0[1], r1[1]}; OUT = __builtin_bit_cast(bf16x8, w); } while (0)
  PK4(p0, 0, pa0); PK4(p0, 8, pa1); PK4(p1, 0, pa2); PK4(p1, 8, pa3);
#undef PK4
}
template <int NKS> __device__ __forceinline__ void qkt(f32x16& p0, f32x16& p1, const LAS char* Ks, const bf16x8* qr, int r32, int hi) {
  p0 = f32x16{}; p1 = f32x16{};
#pragma unroll
  for (int d0 = 0; d0 < NKS; ++d0) { const int cb = (d0 * 16 + hi * 8) * 2;
    const bf16x8 b0 = *(const LAS bf16x8*)(Ks + KSWZ(r32, cb));
    const bf16x8 b1 = *(const LAS bf16x8*)(Ks + KSWZ(32 + r32, cb));
    p0 = __builtin_amdgcn_mfma_f32_32x32x16_bf16(b0, qr[d0], p0, 0, 0, 0);
    p1 = __builtin_amdgcn_mfma_f32_32x32x16_bf16(b1, qr[d0], p1, 0, 0, 0); }
}
template <int D0> __device__ __forceinline__ void pv_one(f32x16& od, int vb, bf16x8 pa0, bf16x8 pa1, bf16x8 pa2, bf16x8 pa3) {
  const s16x4 l0 = tr_read<v_rd_off(D0, 0, 0)>(vb), h0 = tr_read<v_rd_off(D0, 0, 1)>(vb), l1 = tr_read<v_rd_off(D0, 1, 0)>(vb), h1 = tr_read<v_rd_off(D0, 1, 1)>(vb);
  const s16x4 l2 = tr_read<v_rd_off(D0, 2, 0)>(vb), h2 = tr_read<v_rd_off(D0, 2, 1)>(vb), l3 = tr_read<v_rd_off(D0, 3, 0)>(vb), h3 = tr_read<v_rd_off(D0, 3, 1)>(vb);
  asm volatile("s_waitcnt lgkmcnt(0)" ::: "memory"); SBAR();
#define PK(L, H) (bf16x8){L[0], L[1], L[2], L[3], H[0], H[1], H[2], H[3]}
  od = __builtin_amdgcn_mfma_f32_32x32x16_bf16(pa0, PK(l0, h0), od, 0, 0, 0);
  od = __builtin_amdgcn_mfma_f32_32x32x16_bf16(pa1, PK(l1, h1), od, 0, 0, 0);
  od = __builtin_amdgcn_mfma_f32_32x32x16_bf16(pa2, PK(l2, h2), od, 0, 0, 0);
  od = __builtin_amdgcn_mfma_f32_32x32x16_bf16(pa3, PK(l3, h3), od, 0, 0, 0);
#undef PK
}
__device__ __forceinline__ void pv2(f32x16* o, int vb, bf16x8 pa0, bf16x8 pa1, bf16x8 pa2, bf16x8 pa3) { pv_one<0>(o[0], vb, pa0, pa1, pa2, pa3); pv_one<1>(o[1], vb, pa0, pa1, pa2, pa3); }
__device__ __forceinline__ void pv2b(f32x16* o, int vb, bf16x8 pa0, bf16x8 pa1, bf16x8 pa2, bf16x8 pa3) {
  const s16x4 a0 = tr_read<v_rd_off(0, 0, 0)>(vb), b0 = tr_read<v_rd_off(0, 0, 1)>(vb), a1 = tr_read<v_rd_off(0, 1, 0)>(vb), b1 = tr_read<v_rd_off(0, 1, 1)>(vb);
  const s16x4 a2 = tr_read<v_rd_off(0, 2, 0)>(vb), b2 = tr_read<v_rd_off(0, 2, 1)>(vb), a3 = tr_read<v_rd_off(0, 3, 0)>(vb), b3 = tr_read<v_rd_off(0, 3, 1)>(vb);
  const s16x4 c0 = tr_read<v_rd_off(1, 0, 0)>(vb), d0 = tr_read<v_rd_off(1, 0, 1)>(vb), c1 = tr_read<v_rd_off(1, 1, 0)>(vb), d1 = tr_read<v_rd_off(1, 1, 1)>(vb);
  const s16x4 c2 = tr_read<v_rd_off(1, 2, 0)>(vb), d2 = tr_read<v_rd_off(1, 2, 1)>(vb), c3 = tr_read<v_rd_off(1, 3, 0)>(vb), d3 = tr_read<v_rd_off(1, 3, 1)>(vb);
  asm volatile("s_waitcnt lgkmcnt(0)" ::: "memory"); SBAR();
#define PK(L, H) (bf16x8){L[0], L[1], L[2], L[3], H[0], H[1], H[2], H[3]}
  o[0] = __builtin_amdgcn_mfma_f32_32x32x16_bf16(pa0, PK(a0, b0), o[0], 0, 0, 0); o[1] = __builtin_amdgcn_mfma_f32_32x32x16_bf16(pa0, PK(c0, d0), o[1], 0, 0, 0);
  o[0] = __builtin_amdgcn_mfma_f32_32x32x16_bf16(pa1, PK(a1, b1), o[0], 0, 0, 0); o[1] = __builtin_amdgcn_mfma_f32_32x32x16_bf16(pa1, PK(c1, d1), o[1], 0, 0, 0);
  o[0] = __builtin_amdgcn_mfma_f32_32x32x16_bf16(pa2, PK(a2, b2), o[0], 0, 0, 0); o[1] = __builtin_amdgcn_mfma_f32_32x32x16_bf16(pa2, PK(c2, d2), o[1], 0, 0, 0);
  o[0] = __builtin_amdgcn_mfma_f32_32x32x16_bf16(pa3, PK(a3, b3), o[0], 0, 0, 0); o[1] = __builtin_amdgcn_mfma_f32_32x32x16_bf16(pa3, PK(c3, d3), o[1], 0, 0, 0);
#undef PK
}
#define ATT_RESC(a) do { if (__any((a) < 1.f)) { if (hi == 0) al_l[r32] = (a); asm volatile("s_waitcnt lgkmcnt(0)" ::: "memory"); \
    _Pragma("unroll") for (int d = 0; d < 2; ++d) _Pragma("unroll") for (int r = 0; r < 16; ++r) o[d][r] *= al_l[crow(r, hi)]; } } while (0)

constexpr int M2_K = 0, M2_V = 4 * SHM_K, M2_WS = M2_V + 4 * SHM_V, M2_END = M2_WS + 8 * 256;
__device__ __forceinline__ void glds16(unsigned voff, const void* sbase, unsigned lds_dst) { unsigned keep;
  asm volatile("s_mov_b32 %0, m0\n\ts_mov_b32 m0, %3\n\ts_nop 0\n\tglobal_load_lds_dwordx4 %1, %2\n\ts_mov_b32 m0, %0" : "=&s"(keep) : "v"(voff), "s"(sbase), "s"(lds_dst) : "memory"); }
#define MLA_WAIT_BAR() asm volatile("s_waitcnt vmcnt(0) lgkmcnt(0)\n\ts_barrier" ::: "memory")
__device__ __forceinline__ void packP(const f32x16& p0, const f32x16& p1, float alpha, float& l_reg, bf16x8& pa0, bf16x8& pa1, bf16x8& pa2, bf16x8& pa3) {
  float s0 = p0[0], s1 = p0[8], s2 = p1[0], s3 = p1[8];
#pragma unroll
  for (int r = 1; r < 8; ++r) { s0 += p0[r]; s1 += p0[8 + r]; s2 += p1[r]; s3 += p1[8 + r]; }
  float ps = (s0 + s1) + (s2 + s3);
  { auto rr = __builtin_amdgcn_permlane32_swap(__float_as_uint(ps), __float_as_uint(ps), false, false);
    ps = __uint_as_float(rr[0]) + __uint_as_float(rr[1]); }
  l_reg = l_reg * alpha + ps;
#define PK4N(P, BASE, OUT) do { u32x4 w = {cvt_pk_bf16(P[BASE + 0], P[BASE + 1]), cvt_pk_bf16(P[BASE + 2], P[BASE + 3]), cvt_pk_bf16(P[BASE + 4], P[BASE + 5]), cvt_pk_bf16(P[BASE + 6], P[BASE + 7])}; OUT = __builtin_bit_cast(bf16x8, w); } while (0)
  PK4N(p0, 0, pa0); PK4N(p0, 8, pa1); PK4N(p1, 0, pa2); PK4N(p1, 8, pa3);
#undef PK4N
}
__device__ __forceinline__ void finishSM2(f32x16& p0, f32x16& p1, float alpha, float& l_reg, bf16x8& pa0, bf16x8& pa1, bf16x8& pa2, bf16x8& pa3) {
#pragma unroll
  for (int r = 0; r < 16; ++r) p1[r] = __builtin_amdgcn_exp2f(p1[r]);
  packP(p0, p1, alpha, l_reg, pa0, pa1, pa2, pa3);
}
__device__ __forceinline__ void partialSM2(f32x16& p0, f32x16& p1, float& m_reg, f32x16& negm, float& alpha, const float THRL) {
  float ma = fmaxf(fmaxf(p0[0], p0[1]), p0[2]), mb = fmaxf(fmaxf(p1[0], p1[1]), p1[2]);
#pragma unroll
  for (int r = 3; r < 15; r += 2) { ma = fmaxf(fmaxf(ma, p0[r]), p0[r + 1]); mb = fmaxf(fmaxf(mb, p1[r]), p1[r + 1]); }
  float pmax = fmaxf(fmaxf(ma, p0[15]), fmaxf(mb, p1[15]));
  if (__builtin_expect(__all(pmax <= THRL), 1)) { alpha = 1.f; }
  else { { auto rr = __builtin_amdgcn_permlane32_swap(__float_as_uint(pmax), __float_as_uint(pmax), false, false);
           pmax = fmaxf(__uint_as_float(rr[0]), __uint_as_float(rr[1])); }
    const float dl = fmaxf(pmax, 0.f); m_reg += dl; alpha = __builtin_amdgcn_exp2f(-dl);
#pragma unroll
    for (int r = 0; r < 16; ++r) { p0[r] -= dl; p1[r] -= dl; }
#pragma unroll
    for (int r = 0; r < 16; ++r) negm[r] = -m_reg;
    asm volatile("" : "+v"(negm)); }
#pragma unroll
  for (int r = 0; r < 16; ++r) p0[r] = __builtin_amdgcn_exp2f(p0[r]);
}
template <int NKS> __device__ __forceinline__ void qkt_m(f32x16& p0, f32x16& p1, const LAS char* Ks, const bf16x8* qr, const f32x16& negm, int r32, int hi) {
  bf16x8 kf[2 * NKS];
#pragma unroll
  for (int d0 = 0; d0 < NKS; ++d0) { const int cb = (d0 * 16 + hi * 8) * 2;
    kf[2 * d0] = *(const LAS bf16x8*)(Ks + KSWZ(r32, cb)); kf[2 * d0 + 1] = *(const LAS bf16x8*)(Ks + KSWZ(32 + r32, cb)); }
  SBAR();
#pragma unroll
  for (int d0 = 0; d0 < NKS; ++d0) {
    if (d0 == 0) { p0 = __builtin_amdgcn_mfma_f32_32x32x16_bf16(kf[0], qr[0], negm, 0, 0, 0); p1 = __builtin_amdgcn_mfma_f32_32x32x16_bf16(kf[1], qr[0], negm, 0, 0, 0); }
    else { p0 = __builtin_amdgcn_mfma_f32_32x32x16_bf16(kf[2 * d0], qr[d0], p0, 0, 0, 0); p1 = __builtin_amdgcn_mfma_f32_32x32x16_bf16(kf[2 * d0 + 1], qr[d0], p1, 0, 0, 0); } }
}
template <int OFF> __device__ __forceinline__ bf16x8 lds_rd128(int a) { bf16x8 r; asm volatile("ds_read_b128 %0, %1 offset:%2" : "=&v"(r) : "v"(a), "i"(OFF) : "memory"); return r; }
__device__ __forceinline__ void mla_mseg(f32x16& p0, f32x16& p1, f32x16* o, int kb, int vb, const bf16x8* qr, const f32x16& negm, bf16x8 pa0, bf16x8 pa1, bf16x8 pa2, bf16x8 pa3, int r32, int hi) {
  bf16x8 kf[12];
#pragma unroll
  for (int d = 0; d < 6; ++d) { const int a = kb + KSWZ(r32, (d * 16 + hi * 8) * 2); kf[2 * d] = lds_rd128<0>(a); kf[2 * d + 1] = lds_rd128<8192>(a); }
#define KW(N, A, B) asm volatile("s_waitcnt lgkmcnt(" #N ")" : "+v"(A), "+v"(B) :: "memory")
  KW(10, kf[0], kf[1]); p0 = __builtin_amdgcn_mfma_f32_32x32x16_bf16(kf[0], qr[0], negm, 0, 0, 0); p1 = __builtin_amdgcn_mfma_f32_32x32x16_bf16(kf[1], qr[0], negm, 0, 0, 0);
  SBAR(); KW(8, kf[2], kf[3]); p0 = __builtin_amdgcn_mfma_f32_32x32x16_bf16(kf[2], qr[1], p0, 0, 0, 0); p1 = __builtin_amdgcn_mfma_f32_32x32x16_bf16(kf[3], qr[1], p1, 0, 0, 0);
  SBAR(); KW(6, kf[4], kf[5]); p0 = __builtin_amdgcn_mfma_f32_32x32x16_bf16(kf[4], qr[2], p0, 0, 0, 0); p1 = __builtin_amdgcn_mfma_f32_32x32x16_bf16(kf[5], qr[2], p1, 0, 0, 0);
  SBAR(); KW(4, kf[6], kf[7]); p0 = __builtin_amdgcn_mfma_f32_32x32x16_bf16(kf[6], qr[3], p0, 0, 0, 0); p1 = __builtin_amdgcn_mfma_f32_32x32x16_bf16(kf[7], qr[3], p1, 0, 0, 0);
#undef KW
  SBAR();
  const s16x4 a0 = tr_read<v_rd_off(0, 0, 0)>(vb), b0 = tr_read<v_rd_off(0, 0, 1)>(vb), c0 = tr_read<v_rd_off(1, 0, 0)>(vb), d0 = tr_read<v_rd_off(1, 0, 1)>(vb);
  const s16x4 a1 = tr_read<v_rd_off(0, 1, 0)>(vb), b1 = tr_read<v_rd_off(0, 1, 1)>(vb), c1 = tr_read<v_rd_off(1, 1, 0)>(vb), d1 = tr_read<v_rd_off(1, 1, 1)>(vb);
  const s16x4 a2 = tr_read<v_rd_off(0, 2, 0)>(vb), b2 = tr_read<v_rd_off(0, 2, 1)>(vb), c2 = tr_read<v_rd_off(1, 2, 0)>(vb), d2 = tr_read<v_rd_off(1, 2, 1)>(vb);
  const s16x4 a3 = tr_read<v_rd_off(0, 3, 0)>(vb), b3 = tr_read<v_rd_off(0, 3, 1)>(vb), c3 = tr_read<v_rd_off(1, 3, 0)>(vb), d3 = tr_read<v_rd_off(1, 3, 1)>(vb);
  asm volatile("s_waitcnt lgkmcnt(15)" : "+v"(kf[8]), "+v"(kf[9]), "+v"(kf[10]), "+v"(kf[11]) :: "memory");
  p0 = __builtin_amdgcn_mfma_f32_32x32x16_bf16(kf[8], qr[4], p0, 0, 0, 0); p1 = __builtin_amdgcn_mfma_f32_32x32x16_bf16(kf[9], qr[4], p1, 0, 0, 0);
  p0 = __builtin_amdgcn_mfma_f32_32x32x16_bf16(kf[10], qr[5], p0, 0, 0, 0); p1 = __builtin_amdgcn_mfma_f32_32x32x16_bf16(kf[11], qr[5], p1, 0, 0, 0);
  SBAR(); asm volatile("s_waitcnt lgkmcnt(0)" ::: "memory"); SBAR();
#define PK(L, H) (bf16x8){L[0], L[1], L[2], L[3], H[0], H[1], H[2], H[3]}
  o[0] = __builtin_amdgcn_mfma_f32_32x32x16_bf16(pa0, PK(a0, b0), o[0], 0, 0, 0); o[1] = __builtin_amdgcn_mfma_f32_32x32x16_bf16(pa0, PK(c0, d0), o[1], 0, 0, 0);
  o[0] = __builtin_amdgcn_mfma_f32_32x32x16_bf16(pa1, PK(a1, b1), o[0], 0, 0, 0); o[1] = __builtin_amdgcn_mfma_f32_32x32x16_bf16(pa1, PK(c1, d1), o[1], 0, 0, 0);
  o[0] = __builtin_amdgcn_mfma_f32_32x32x16_bf16(pa2, PK(a2, b2), o[0], 0, 0, 0); o[1] = __builtin_amdgcn_mfma_f32_32x32x16_bf16(pa2, PK(c2, d2), o[1], 0, 0, 0);
  o[0] = __builtin_amdgcn_mfma_f32_32x32x16_bf16(pa3, PK(a3, b3), o[0], 0, 0, 0); o[1] = __builtin_amdgcn_mfma_f32_32x32x16_bf16(pa3, PK(c3, d3), o[1], 0, 0, 0);
#undef PK
}
__device__ __forceinline__ void mla_unit(int b, int h, int qb, int kh, const bf16_t* __restrict__ QB, const bf16_t* __restrict__ KVB, const bf16_t* __restrict__ KR, bf16_t* __restrict__ OA, f32x2* __restrict__ ML, LAS char* lds) {
  int tid = threadIdx.x; asm volatile("" : "+v"(tid));
  const int wid = __builtin_amdgcn_readfirstlane(tid >> 6), lane = tid & 63, r32 = lane & 31, hi = lane >> 5;
  LAS char* K_lds = lds + M2_K;
  LAS float* wsf = (LAS float*)(lds + M2_WS) + wid * 64; LAS float* li_l = wsf; LAS float* al_l = wsf + 32;
  constexpr float SCALE = 0.10206207261596575f, C = SCALE * 1.4426950408889634f, THRL = 8.0f * 1.4426950408889634f;
  const long rowbase = (long)b * SEQ; const int qpos = qb * 256 + wid * 32 + r32;
  const long keybase = rowbase + (long)kh * (SEQ / 2);
  const char* const sbase = (const char*)KVB < (const char*)KR ? (const char*)KVB : (const char*)KR;
  const unsigned okv = (unsigned)((const char*)KVB - sbase), okr = (unsigned)((const char*)KR - sbase);
  unsigned ksrc[2], kstr[2];
#pragma unroll
  for (int i = 0; i < 2; ++i) { const int p = wid * 2 + i, row = 4 * p + (lane >> 4), c = (lane & 15) ^ (row & 15);
    if (c < 8) { ksrc[i] = okv + (unsigned)(((keybase + row) * 768 + h * 128 + c * 8) * 2); kstr[i] = 64u * 768u * 2u; }
    else { const int rc = c - 8; ksrc[i] = okr + (unsigned)(((keybase + row) * 32 + ((rc < 4 ? rc : 0) * 8)) * 2); kstr[i] = 64u * 32u * 2u; } }
  unsigned vsrc = okv + (unsigned)(((keybase + 8 * wid + ((lane & 31) >> 2)) * 768 + h * 128 + 64 + (lane >> 5) * 32 + (lane & 3) * 8) * 2);
  const unsigned lds0 = (unsigned)(size_t)lds;
  const unsigned kdst = lds0 + M2_K + wid * 2048, vdst = lds0 + M2_V + wid * 1024;
#define MLA_DMA(slot) do { glds16(ksrc[0], sbase, (unsigned)__builtin_amdgcn_readfirstlane(kdst + (slot) * SHM_K)); glds16(ksrc[1], sbase, (unsigned)__builtin_amdgcn_readfirstlane(kdst + (slot) * SHM_K + 1024)); \
    glds16(vsrc, sbase, (unsigned)__builtin_amdgcn_readfirstlane(vdst + (slot) * SHM_V)); ksrc[0] += kstr[0]; ksrc[1] += kstr[1]; vsrc += 64u * 768u * 2u; } while (0)
  MLA_DMA(0);
  float m_reg = 0.f, l_reg = 0.f; f32x16 o[2] = {}; bf16x8 qr[6];
  { const bf16_t* Qw = QB + (rowbase + qpos) * 768 + h * 96 + hi * 8;
#pragma unroll
    for (int d0 = 0; d0 < 6; ++d0) qr[d0] = *(const bf16x8*)(Qw + d0 * 16);
#pragma unroll
    for (int d0 = 0; d0 < 4; ++d0) { u32x4 x = __builtin_bit_cast(u32x4, qr[d0]);
#pragma unroll
      for (int i = 0; i < 4; ++i) x[i] = cvt_pk_bf16(bflo(x[i]) * C, bfhi(x[i]) * C);
      qr[d0] = __builtin_bit_cast(bf16x8, x); }
    u32x4 x1 = __builtin_bit_cast(u32x4, qr[4]), x2 = __builtin_bit_cast(u32x4, qr[5]); u32x4 y1, y2;
#pragma unroll
    for (int i = 0; i < 4; ++i) { float c0, s0, c1, s1; rope_cs(qpos, hi * 8 + 2 * i, c0, s0); rope_cs(qpos, hi * 8 + 2 * i + 1, c1, s1);
      const float a0 = bflo(x1[i]) * C, a1 = bfhi(x1[i]) * C, b0 = bflo(x2[i]) * C, b1 = bfhi(x2[i]) * C;
      y1[i] = cvt_pk_bf16(a0 * c0 - b0 * s0, a1 * c1 - b1 * s1); y2[i] = cvt_pk_bf16(a0 * s0 + b0 * c0, a1 * s1 + b1 * c1); }
    qr[4] = __builtin_bit_cast(bf16x8, y1); qr[5] = __builtin_bit_cast(bf16x8, y2); }
  const int vb0 = (int)lds0 + M2_V + v_rd_base(lane);
  f32x16 p0, p1; float al = 1.f; bf16x8 pa0, pa1, pa2, pa3; constexpr int NT = SEQ / 128;
  f32x16 negm = f32x16{}; asm volatile("" : "+v"(negm)); m_reg = 0.f;
  const int grp = wid >> 2;
#define MLA_BAR_L() asm volatile("s_waitcnt lgkmcnt(0)\n\ts_barrier" ::: "memory")
#define MLA_BAR_V3() asm volatile("s_waitcnt vmcnt(3) lgkmcnt(0)\n\ts_barrier" ::: "memory")
#define MLA_SOFTMAX() do { SBAR(); partialSM2(p0, p1, m_reg, negm, al, THRL); finishSM2(p0, p1, al, l_reg, pa0, pa1, pa2, pa3); ATT_RESC(al); SBAR(); } while (0)
#define MLA_MSEG(sk_, sv_) do { SBAR(); __builtin_amdgcn_s_setprio(2); mla_mseg(p0, p1, o, (int)lds0 + M2_K + (sk_) * SHM_K, vb0 + (sv_) * SHM_V, qr, negm, pa0, pa1, pa2, pa3, r32, hi); __builtin_amdgcn_s_setprio(0); SBAR(); } while (0)
  MLA_DMA(1);
  MLA_WAIT_BAR();
  if (grp == 0) {
    SBAR(); qkt_m<6>(p0, p1, K_lds, qr, negm, r32, hi); SBAR();
    MLA_BAR_L();
    if (2 < NT) MLA_DMA(2);
    MLA_SOFTMAX();
    MLA_BAR_V3();
#pragma unroll 1
    for (int j = 1; j < NT; ++j) {
      MLA_MSEG(j & 3, (j - 1) & 3);
      MLA_BAR_L();
      if (j + 2 < NT) MLA_DMA((j + 2) & 3);
      MLA_SOFTMAX();
      if (j + 2 < NT) MLA_BAR_V3(); else MLA_WAIT_BAR();
    }
    SBAR(); pv2b(o, vb0 + ((NT - 1) & 3) * SHM_V, pa0, pa1, pa2, pa3); SBAR();
    MLA_BAR_L();
    MLA_WAIT_BAR();
  } else {
    if (2 < NT) MLA_DMA(2);
    MLA_BAR_L();
    SBAR(); qkt_m<6>(p0, p1, K_lds, qr, negm, r32, hi); SBAR();
    MLA_BAR_V3();
#pragma unroll 1
    for (int j = 1; j < NT; ++j) {
      if (j + 2 < NT) MLA_DMA((j + 2) & 3);
      MLA_SOFTMAX();
      MLA_BAR_L();
      MLA_MSEG(j & 3, (j - 1) & 3);
      if (j + 2 < NT) MLA_BAR_V3(); else MLA_WAIT_BAR();
    }
    MLA_SOFTMAX();
    MLA_BAR_L();
    SBAR(); pv2b(o, vb0 + ((NT - 1) & 3) * SHM_V, pa0, pa1, pa2, pa3); SBAR();
    MLA_WAIT_BAR();
  }
#undef MLA_BAR_L
#undef MLA_BAR_V3
#undef MLA_SOFTMAX
#undef MLA_MSEG
#undef MLA_DMA
  if (hi == 0) li_l[r32] = l_reg;
  asm volatile("s_waitcnt lgkmcnt(0)" ::: "memory");
  if (hi == 0) ML[((size_t)(3 + kh) * MTOK + rowbase + qpos) * 8 + h] = (f32x2){0.6931471805599453f * m_reg, l_reg};
  bf16_t* Ow = OA + ((size_t)(3 + kh) * MTOK + rowbase + qb * 256 + wid * 32) * 384 + h * 64 + r32;
#pragma unroll
  for (int r = 0; r < 16; ++r) { const int orow = crow(r, hi); const float rl = __builtin_amdgcn_rcpf(li_l[orow]);
#pragma unroll
    for (int d0 = 0; d0 < 2; ++d0) Ow[(long)orow * 384 + d0 * 32] = (bf16_t)(cvt_pk_bf16(o[d0][r] * rl, 0.f) & 0xffffu); }
  asm volatile("s_waitcnt lgkmcnt(0)\n\ts_barrier" ::: "memory");
}

constexpr int WT_BYTES = 16384;
constexpr int W_RPB = 6 * WT_BYTES, W_WS = W_RPB + 2560, W_END = W_WS + 8 * 256;
#define KSWZ128(row, colB) ((row) * 128 + ((colB) ^ ((((row) >> 1) & 7) << 4)))
__device__ __forceinline__ void qkt128(f32x16& p0, f32x16& p1, const LAS char* Ks, const bf16x8* qr, int r32, int hi) {
  p0 = f32x16{}; p1 = f32x16{};
#pragma unroll
  for (int d0 = 0; d0 < 4; ++d0) { const int cb = (d0 * 16 + hi * 8) * 2;
    const bf16x8 b0 = *(const LAS bf16x8*)(Ks + KSWZ128(r32, cb));
    const bf16x8 b1 = *(const LAS bf16x8*)(Ks + KSWZ128(32 + r32, cb));
    p0 = __builtin_amdgcn_mfma_f32_32x32x16_bf16(b0, qr[d0], p0, 0, 0, 0);
    p1 = __builtin_amdgcn_mfma_f32_32x32x16_bf16(b1, qr[d0], p1, 0, 0, 0); }
}
#define WIN_SOFTMAX_PV(slot) do { float al_, mn_; bf16x8 pa0, pa1, pa2, pa3; partialSM(p0, p1, m_reg, mn_, al_, C, THRR); finishSM(p0, p1, al_, l_reg, pa0, pa1, pa2, pa3); \
    ATT_RESC(al_); pv2(o, vb0 + (slot) * WT_BYTES, pa0, pa1, pa2, pa3); } while (0)

__device__ __forceinline__ void dil_phase(int ua0, int na, const bf16_t* __restrict__ PROJ, bf16_t* __restrict__ OA, f32x2* __restrict__ ML, LAS char* lds) {
  int tid = threadIdx.x; asm volatile("" : "+v"(tid));
  const int wid = __builtin_amdgcn_readfirstlane(tid >> 6), lane = tid & 63, r32 = lane & 31, hi = lane >> 5;
  LAS float* wsf = (LAS float*)(lds + W_WS) + wid * 64; LAS float* li_l = wsf; LAS float* al_l = wsf + 32;
  constexpr float SCALE = 0.125f, C = SCALE * 1.4426950408889634f, THRR = 8.0f / SCALE;
  const int srow = tid >> 3, sc8 = tid & 7;
  const int kst = KSWZ128(srow, sc8 * 16), vst = 8192 + v_st(srow, sc8 * 8);
  const int vb0 = (int)(unsigned)(size_t)lds + 8192 + v_rd_base(lane);
  bf16x8 sk[6], sv[6], qn[4];
#define DIL_GEO(ua) const int bh_ = (ua) / 96, rem_ = (ua) % 96, g = rem_ >> 5, uu_ = rem_ & 31, h = bh_ % 6; const long rowbase = (long)(bh_ / 6) * SEQ; \
    const int d = (g == 0) ? 1 : ((g == 1) ? 4 : 16), n = SEQ / d, res = uu_ % d, i0 = (uu_ / d) * 256
#define DIL_LOAD(ua) do { DIL_GEO(ua); _Pragma("unroll") for (int t = 0; t < 6; ++t) { int ki = i0 - 64 + 64 * t + srow; ki = min(max(ki, 0), n - 1); \
      const bf16_t* p_ = PROJ + (rowbase + (long)ki * d + res) * PJ + h * 64 + sc8 * 8; sk[t] = *(const bf16x8*)(p_ + PC_KA); sv[t] = *(const bf16x8*)(p_ + PC_VA); } \
    const bf16_t* Qw = PROJ + (rowbase + (long)(i0 + wid * 32 + r32) * d + res) * PJ + PC_QA + h * 64 + hi * 8; \
    _Pragma("unroll") for (int d0 = 0; d0 < 4; ++d0) qn[d0] = *(const bf16x8*)(Qw + d0 * 16); } while (0)
  if (na > 0) DIL_LOAD(ua0);
#pragma unroll 1
  for (int k = 0; k < na; ++k) {
    DIL_GEO(ua0 + k);
#pragma unroll
    for (int t = 0; t < 6; ++t) { *(LAS bf16x8*)(lds + t * WT_BYTES + kst) = sk[t]; *(LAS bf16x8*)(lds + t * WT_BYTES + vst) = sv[t]; }
    bf16x8 qr[4];
#pragma unroll
    for (int d0 = 0; d0 < 4; ++d0) qr[d0] = qn[d0];
    __syncthreads();
    if (k + 1 < na) DIL_LOAD(ua0 + k + 1);
    const int qi = i0 + wid * 32 + r32;
    const float slope = 8.0f * exp2f(-8.0f * (float)(h + 1) / 6.0f) * (float)d;
    float m_reg = -1e30f, l_reg = 0.f; f32x16 o[2] = {};
#pragma unroll 1
    for (int tt = 0; tt < 3; ++tt) {
      const int t = (wid >> 1) + tt;
      const int tstart = i0 - 64 + 64 * t;
      if (tstart < 0 || tstart >= n) continue;
      f32x16 p0, p1;
      qkt128(p0, p1, lds + t * WT_BYTES, qr, r32, hi);
      const float kbf = (float)(tstart - qi + 4 * hi);
#pragma unroll
      for (int r = 0; r < 16; ++r) { const float dl0 = kbf + (float)((r & 3) + 8 * (r >> 2)), dl1 = dl0 + 32.0f;
        p0[r] = (fabsf(dl0) <= 64.0f) ? fmaf(-slope, fabsf(dl0), p0[r]) : -1e30f; p1[r] = (fabsf(dl1) <= 64.0f) ? fmaf(-slope, fabsf(dl1), p1[r]) : -1e30f; }
      WIN_SOFTMAX_PV(t);
    }
    if (hi == 0) li_l[r32] = l_reg;
    asm volatile("s_waitcnt lgkmcnt(0)" ::: "memory");
    if (hi == 0) ML[((size_t)g * MTOK + rowbase + (long)qi * d + res) * 8 + h] = (f32x2){SCALE * m_reg, l_reg};
#pragma unroll
    for (int r = 0; r < 16; ++r) { const int orow = crow(r, hi); const float rl = __builtin_amdgcn_rcpf(li_l[orow]);
      bf16_t* Ow = OA + ((size_t)g * MTOK + rowbase + (long)(i0 + wid * 32 + orow) * d + res) * 384 + h * 64 + r32;
#pragma unroll
      for (int d0 = 0; d0 < 2; ++d0) Ow[d0 * 32] = (bf16_t)(cvt_pk_bf16(o[d0][r] * rl, 0.f) & 0xffffu); }
    __syncthreads();
  }
#undef DIL_GEO
#undef DIL_LOAD
}

__device__ __forceinline__ void nat_phase(int uc0, int nc, const bf16_t* __restrict__ PROJ, bf16_t* __restrict__ YC, const float* __restrict__ rpb_l, LAS char* lds) {
  int tid = threadIdx.x; asm volatile("" : "+v"(tid));
  const int wid = __builtin_amdgcn_readfirstlane(tid >> 6), lane = tid & 63, r32 = lane & 31, hi = lane >> 5;
  LAS float* wsf = (LAS float*)(lds + W_WS) + wid * 64; LAS float* li_l = wsf; LAS float* al_l = wsf + 32; LAS float* rpbL = (LAS float*)(lds + W_RPB + 256);
  constexpr float SCALE = 0.125f, C = SCALE * 1.4426950408889634f, THRR = 8.0f / SCALE;
  const int srow = tid >> 3, sc8 = tid & 7;
  const int kst = KSWZ128(srow, sc8 * 16), vst = 8192 + v_st(srow, sc8 * 8);
  const int vb0 = (int)(unsigned)(size_t)lds + 8192 + v_rd_base(lane);
  bf16x8 sk[6], sv[6], qn[4];
#define NAT_GEO(uc) const int bh_ = (uc) >> 5, uu = (uc) & 31, h = bh_ & 3; const long rowbase = (long)(bh_ >> 2) * SEQ; const bool edge = (uu == 0 || uu == 31); const int R0 = min(max(4 * uu - 4, 0), 120)
#define NAT_RL(s, t) (edge ? ((s) * 6 + (t)) : ((s) == 0 ? ((t) < 3 ? (t) : (t) + 5) : (t) + 3))
#define NAT_NT(s) (edge ? ((s) == 0 ? 6 : 2) : ((s) == 0 ? 6 : 5))
#define NAT_LOAD(uc, s) do { NAT_GEO(uc); _Pragma("unroll") for (int t = 0; t < 6; ++t) { const int rl_ = min(NAT_RL(s, t), edge ? 7 : 10); \
      const bf16_t* p_ = PROJ + (rowbase + (long)(R0 + rl_) * 64 + srow) * PJ + h * 64 + sc8 * 8; sk[t] = *(const bf16x8*)(p_ + PC_KC); sv[t] = *(const bf16x8*)(p_ + PC_VC); } \
    if ((s) == 0) { const bf16_t* Qw = PROJ + (rowbase + 256 * uu + 32 * wid + r32) * PJ + PC_QC + h * 64 + hi * 8; \
      _Pragma("unroll") for (int d0 = 0; d0 < 4; ++d0) qn[d0] = *(const bf16x8*)(Qw + d0 * 16); } } while (0)
  if (nc > 0) NAT_LOAD(uc0, 0);
  float m_reg = -1e30f, l_reg = 0.f; f32x16 o[2] = {}; bf16x8 qr[4] = {};
#pragma unroll 1
  for (int st = 0; st < 2 * nc; ++st) {
    const int s = st & 1; NAT_GEO(uc0 + (st >> 1));
#pragma unroll
    for (int t = 0; t < 6; ++t) { *(LAS bf16x8*)(lds + t * WT_BYTES + kst) = sk[t]; *(LAS bf16x8*)(lds + t * WT_BYTES + vst) = sv[t]; }
    if (s == 0) {
#pragma unroll
      for (int d0 = 0; d0 < 4; ++d0) qr[d0] = qn[d0];
      for (int t = tid; t < 15 * 31; t += 512) rpbL[t] = rpb_l[h * 465 + t] * 8.0f;
      m_reg = -1e30f; l_reg = 0.f; o[0] = f32x16{}; o[1] = f32x16{};
    }
    __syncthreads();
    if (st + 1 < 2 * nc) { if (s == 0) NAT_LOAD(uc0 + (st >> 1), 1); else NAT_LOAD(uc0 + (st >> 1) + 1, 0); }
    const int rq = 4 * uu + (wid >> 1), cq = 32 * (wid & 1) + r32, rs = min(max(rq - 4, 0), 120), cs = min(max(cq - 8, 0), 48);
    const int ntl = NAT_NT(s);
#pragma unroll 1
    for (int t = 0; t < ntl; ++t) {
      const int kr = R0 + NAT_RL(s, t);
      if (kr >= rs && kr < rs + 8) {
        f32x16 p0, p1;
        qkt128(p0, p1, lds + t * WT_BYTES, qr, r32, hi);
        const LAS float* bp = rpbL + ((kr - rq + 7) * 31 + 15 - cq + 4 * hi);
        const unsigned t0 = (unsigned)(4 * hi - cs);
#pragma unroll
        for (int r = 0; r < 16; ++r) { const int c0 = (r & 3) + 8 * (r >> 2);
          p0[r] = (t0 + (unsigned)c0 < 16u) ? p0[r] + bp[c0] : -1e30f; p1[r] = (t0 + (unsigned)(c0 + 32) < 16u) ? p1[r] + bp[c0 + 32] : -1e30f; }
        WIN_SOFTMAX_PV(t);
      }
    }
    if (s == 1) {
      if (hi == 0) li_l[r32] = l_reg;
      asm volatile("s_waitcnt lgkmcnt(0)" ::: "memory");
#pragma unroll
      for (int r = 0; r < 16; ++r) { const int orow = crow(r, hi); const float rl = __builtin_amdgcn_rcpf(li_l[orow]);
        bf16_t* Ow = YC + (rowbase + 256 * uu + 32 * wid + orow) * 256 + h * 64 + r32;
#pragma unroll
        for (int d0 = 0; d0 < 2; ++d0) Ow[d0 * 32] = (bf16_t)(cvt_pk_bf16(o[d0][r] * rl, 0.f) & 0xffffu); }
    }
    __syncthreads();
  }
#undef NAT_GEO
#undef NAT_RL
#undef NAT_NT
#undef NAT_LOAD
}
#undef WIN_SOFTMAX_PV
#undef ATT_RESC
}

#define RLX_AGENT __ATOMIC_RELAXED, __HIP_MEMORY_SCOPE_AGENT
#define XB_TMO      128
#define XB_XCNT(j)  (256  + 64 * (j))
#define XB_XSUB(j)  (1280 + 64 * (j))
#define XB_XGEN(j)  (2304 + 64 * (j))
#define XB_TOP      3328
#define XB_TOPGEN   3392
#define XCD_BAR_WORDS 3456
#define XB_SPIN_CAP (1u << 18)
__device__ __forceinline__ unsigned xb_ld(unsigned* p)              { return __hip_atomic_load(p, __ATOMIC_RELAXED, __HIP_MEMORY_SCOPE_AGENT); }
__device__ __forceinline__ unsigned xb_add(unsigned* p, unsigned v) { return __hip_atomic_fetch_add(p, v, __ATOMIC_RELAXED, __HIP_MEMORY_SCOPE_AGENT); }
__device__ __forceinline__ unsigned xb_xcc_id() { return (unsigned)__builtin_amdgcn_s_getreg((3 << 11) | 20) & 0xFu; }
#define XB_SPIN(cond, bar) do { unsigned _sp = 0; while (cond) { __builtin_amdgcn_s_sleep(1); \
    if ((++_sp & 255u) == 0u) { if (xb_ld(&(bar)[XB_TMO])) break; if (_sp > XB_SPIN_CAP) { atomicAdd(&(bar)[XB_TMO], 1u); break; } } } } while (0)
struct XcdBarrier { unsigned* bar; unsigned x; volatile LAS unsigned* st; };
__device__ __forceinline__ XcdBarrier xcd_barrier_post(unsigned* bar, volatile LAS unsigned* st) {
    XcdBarrier b; b.bar = bar; b.x = xb_xcc_id(); b.st = st;
    if (threadIdx.x == 0) (void)xb_add(&bar[XB_XCNT(b.x)], 1u);
    return b;
}
__device__ __forceinline__ void xcd_barrier_complete(unsigned* bar, unsigned x, unsigned& nloc, unsigned& nx) {
    const unsigned G = gridDim.x * gridDim.y * gridDim.z;
    unsigned sum, cnt, mine, sp = 0u;
    for (;;) {
        sum = 0u; cnt = 0u; mine = 0u;
#pragma unroll
        for (unsigned j = 0; j < 16; ++j) { const unsigned c = xb_ld(&bar[XB_XCNT(j)]); sum += c; cnt += (c > 0u) ? 1u : 0u; mine = (j == x) ? c : mine; }
        if (sum == G) break;
        __builtin_amdgcn_s_sleep(1);
        if ((++sp & 255u) == 0u) { if (xb_ld(&bar[XB_TMO])) break; if (sp > XB_SPIN_CAP) { atomicAdd(&bar[XB_TMO], 1u); break; } }
    }
    nloc = mine > 0u ? mine : 1u; nx = cnt > 0u ? cnt : 1u;
}
__device__ __forceinline__ void xcd_barrier(const XcdBarrier& b) {
    asm volatile("s_waitcnt vmcnt(0)" ::: "memory");
    __syncthreads();
    if (threadIdx.x == 0) {
        unsigned* bar = b.bar;
        __builtin_amdgcn_s_waitcnt(0);
        unsigned nloc = b.st[0], nx = b.st[1];
        if (nloc == 0u) { xcd_barrier_complete(bar, b.x, nloc, nx); b.st[0] = nloc; b.st[1] = nx; }
        const unsigned old = xb_add(&bar[XB_XSUB(b.x)], 1u);
        const unsigned gen = old / nloc;
        if (old + 1u == (gen + 1u) * nloc) {
            __builtin_amdgcn_fence(__ATOMIC_RELEASE, "agent");
            asm volatile("s_waitcnt vmcnt(0)" ::: "memory");
            const unsigned og = xb_add(&bar[XB_TOP], 1u);
            const unsigned tg = og / nx;
            if (og + 1u == (tg + 1u) * nx) xb_add(&bar[XB_TOPGEN], 1u);
            else XB_SPIN(xb_ld(&bar[XB_TOPGEN]) == tg, bar);
            __builtin_amdgcn_fence(__ATOMIC_ACQUIRE, "agent");
            xb_add(&bar[XB_XGEN(b.x)], 1u);
            asm volatile("s_waitcnt vmcnt(0)" ::: "memory");
        } else {
            XB_SPIN(xb_ld(&bar[XB_XGEN(b.x)]) == gen, bar);
            __builtin_amdgcn_fence(__ATOMIC_ACQUIRE, "agent");
            asm volatile("s_waitcnt vmcnt(0)" ::: "memory");
        }
    }
    __syncthreads();
}

constexpr int RING_OFF = 0, RING_BYTES = 131072;
constexpr int MISC_OFF = RING_BYTES;
constexpr int LDS_BYTES = 147456;
static_assert(att::L_END <= RING_BYTES && att::W_END <= RING_BYTES && att::M2_END <= RING_BYTES, "attention scratch inside the ring region");

template <class RowMap>
__device__ __forceinline__ void tr_item(const float* __restrict__ W, int K, int N, bf16_t* __restrict__ WT, LAS float* scr, int item, int lane, RowMap rm) {
    const int nblk = N / 32, kb = item / nblk, nb = item % nblk, k0 = 64 * kb, n0 = 32 * nb;
#pragma unroll 8
    for (int i = 0; i < 32; ++i) { const int kk = 2 * i + (lane >> 5); scr[kk * 33 + (lane & 31)] = W[(size_t)(k0 + kk) * N + n0 + (lane & 31)]; }
    LDS_WAIT(); asm volatile("" ::: "memory");
    const int c = lane & 7;
#pragma unroll
    for (int j = 0; j < 4; ++j) { const int n = (lane >> 3) + 8 * j; const LAS float* s = scr + (8 * c) * 33 + n;
        u32x4 o; o.x = cvt_pk_bf16(s[0 * 33], s[1 * 33]); o.y = cvt_pk_bf16(s[2 * 33], s[3 * 33]); o.z = cvt_pk_bf16(s[4 * 33], s[5 * 33]); o.w = cvt_pk_bf16(s[6 * 33], s[7 * 33]);
        *(u32x4*)(WT + (size_t)rm(n0 + n) * K + k0 + 8 * c) = o; }
    LDS_WAIT(); asm volatile("" ::: "memory");
}
struct RmId  { __device__ __forceinline__ int operator()(int n) const { return n; } };
struct RmIn  { __device__ __forceinline__ int operator()(int n) const { return n < 1792 ? n : (n < 1824 ? n + 768 : n - 32); } };
struct RmW1  { __device__ __forceinline__ int operator()(int n) const { return 8 * (n >> 2) + (n & 3); } };
struct RmW3  { __device__ __forceinline__ int operator()(int n) const { return 8 * (n >> 2) + 4 + (n & 3); } };

typedef __attribute__((address_space(4))) const unsigned char* kptr_t;
constexpr int CV_ATT = 16 * 81 + 6 * 18 + 4 * 24 + 16 * 32, CV_FFN = 3 * 16 * 88, CV_MOE = 3 * 8 * 16 * 112;
constexpr int CV_A = CV_ATT + CV_FFN, CV_F1 = CV_A + CV_ATT, CV_F2 = CV_F1 + CV_MOE, CV_F3 = CV_F2 + CV_ATT + CV_FFN, CV_F4 = CV_F3 + CV_ATT, CV_F5 = CV_F4 + CV_MOE, CV_END = CV_F5;
static_assert(CV_ATT == 2012 && CV_FFN == 4224 && CV_MOE == 43008 && CV_END == 102512, "conversion item counts");
struct CvtItem { const float* src; bf16_t* dst; const float* gain; int K, N, kind, k0, n0; };
__device__ __forceinline__ int cvt_row(int kind, int n) { return kind == 0 ? n : (kind == 1 ? (n < 1792 ? n : (n < 1824 ? n + 768 : n - 32)) : 8 * (n >> 2) + (kind == 3 ? 4 : 0) + (n & 3)); }
__device__ __forceinline__ CvtItem cvt_decode(int idx, kptr_t kp, GAS unsigned char* ws) {
#define CV_IN(i) ((const float*)(*(GAS const float* const __attribute__((address_space(4)))*)(kp + 8 * (i))))
#define CV_WS(off) ((bf16_t*)(GAS bf16_t*)(ws + (off)))
    CvtItem t; t.gain = nullptr; int r, g, L, q;
    if (idx < CV_ATT) { g = 0; L = 0; q = idx; } else if (idx < CV_A) { g = 1; L = 0; q = idx - CV_ATT; } else if (idx < CV_F1) { g = 0; L = 1; q = idx - CV_A; }
    else if (idx < CV_F2) { g = 2; L = 0; q = idx - CV_F1; } else if (idx < CV_F2 + CV_ATT) { g = 0; L = 2; q = idx - CV_F2; } else if (idx < CV_F3) { g = 1; L = 1; q = idx - CV_F2 - CV_ATT; }
    else if (idx < CV_F4) { g = 0; L = 3; q = idx - CV_F3; } else { g = 2; L = 1; q = idx - CV_F4; }
    if (g == 0) {
        if (q < 1296) { r = q; t.src = CV_IN(2) + (size_t)L * DM * IN_COLS; t.K = DM; t.N = IN_COLS; t.dst = CV_WS(WS_WIN) + (size_t)L * PJ * DM; t.kind = 1; t.gain = CV_IN(1) + (size_t)L * DM; }
        else if (q < 1404) { r = q - 1296; t.src = CV_IN(5) + (size_t)L * QLR * QUP; t.K = QLR; t.N = QUP; t.dst = CV_WS(WS_WUQ) + (size_t)L * QUP_PAD * QLR; t.kind = 0; t.gain = CV_IN(3) + (size_t)L * QLR; }
        else if (q < 1500) { r = q - 1404; t.src = CV_IN(6) + (size_t)L * KVLR * KVUP; t.K = KVLR; t.N = KVUP; t.dst = CV_WS(WS_WUKV) + (size_t)L * KVUP * KVLR; t.kind = 0; t.gain = CV_IN(4) + (size_t)L * KVLR; }
        else { r = q - 1500; t.src = CV_IN(11) + (size_t)L * DM * DM; t.K = DM; t.N = DM; t.dst = CV_WS(WS_WO) + (size_t)L * DM * DM; t.kind = 0; }
    } else if (g == 1) {
        const int tt = q / 1408; r = q % 1408;
        if (tt < 2) { t.src = CV_IN(tt == 0 ? 13 : 14) + (size_t)L * DM * DFF; t.K = DM; t.N = DFF; t.dst = CV_WS(WS_W13) + (size_t)L * 2 * DFF * DM; t.kind = 2 + tt; t.gain = CV_IN(12) + (size_t)(2 * L) * DM; }
        else { t.src = CV_IN(15) + (size_t)L * DFF * DM; t.K = DFF; t.N = DM; t.dst = CV_WS(WS_W2) + (size_t)L * DM * DFF; t.kind = 0; }
    } else {
        const int tt = q / 14336, mi = L * 8 + (q % 14336) / 1792; r = q % 1792;
        if (tt < 2) { t.src = CV_IN(tt == 0 ? 17 : 18) + (size_t)mi * DM * DFFE; t.K = DM; t.N = DFFE; t.dst = CV_WS(WS_EW13) + (size_t)mi * 2 * DFFE * DM; t.kind = 2 + tt; }
        else { t.src = CV_IN(19) + (size_t)mi * DFFE * DM; t.K = DFFE; t.N = DM; t.dst = CV_WS(WS_EW2) + (size_t)mi * DM * DFFE; t.kind = 0; }
    }
    const int nblk = t.N / 32; t.k0 = 64 * (r / nblk); t.n0 = 32 * (r % nblk); return t;
#undef CV_IN
#undef CV_WS
}
__device__ __forceinline__ void cvt_load(const CvtItem& t, float (&v)[32], int lane) {
#pragma unroll
    for (int i = 0; i < 32; ++i) v[i] = t.src[(size_t)(t.k0 + 2 * i + (lane >> 5)) * t.N + t.n0 + (lane & 31)];
}
__device__ __forceinline__ void cvt_store(const CvtItem& t, const float (&v)[32], LAS float* scr, int lane) {
#pragma unroll
    for (int i = 0; i < 32; ++i) scr[(2 * i + (lane >> 5)) * 33 + (lane & 31)] = v[i];
    LDS_WAIT(); asm volatile("" ::: "memory");
    const int c = lane & 7;
    f32x4 g0 = {1.f, 1.f, 1.f, 1.f}, g1 = g0;
    if (t.gain) { g0 = *(const f32x4*)(t.gain + t.k0 + 8 * c); g1 = *(const f32x4*)(t.gain + t.k0 + 8 * c + 4); }
#pragma unroll
    for (int j = 0; j < 4; ++j) { const int n = (lane >> 3) + 8 * j; const LAS float* s = scr + (8 * c) * 33 + n;
        u32x4 o; o.x = cvt_pk_bf16(s[0 * 33] * g0.x, s[1 * 33] * g0.y); o.y = cvt_pk_bf16(s[2 * 33] * g0.z, s[3 * 33] * g0.w); o.z = cvt_pk_bf16(s[4 * 33] * g1.x, s[5 * 33] * g1.y); o.w = cvt_pk_bf16(s[6 * 33] * g1.z, s[7 * 33] * g1.w);
        *(u32x4*)(t.dst + (size_t)cvt_row(t.kind, t.n0 + n) * t.K + t.k0 + 8 * c) = o; }
    LDS_WAIT(); asm volatile("" ::: "memory");
}
__device__ __forceinline__ void p_prologue(kptr_t kp, GAS unsigned char* ws, LAS unsigned char* lds, int gw, int NGW, int wave, int lane, int gtid, int NGT) {
    asm volatile("" : "+v"(lane), "+v"(gtid));
    LAS float* scr = (LAS float*)(lds + RING_OFF + wave * 16384);
    for (int it = gw; it < CV_END; it += NGW) { const CvtItem t = cvt_decode(it, kp, ws); float v[32]; cvt_load(t, v, lane); cvt_store(t, v, scr, lane); }
    bf16_t* WIN = (bf16_t*)(GAS bf16_t*)(ws + WS_WIN); bf16_t* WUQ = (bf16_t*)(GAS bf16_t*)(ws + WS_WUQ);
    const u32x4 z = {0u, 0u, 0u, 0u};
    for (int i = gtid; i < 4 * (PJ - IN_COLS) * DM / 8; i += NGT) { const int l = i / ((PJ - IN_COLS) * DM / 8), r = i % ((PJ - IN_COLS) * DM / 8); *(u32x4*)(WIN + ((size_t)l * PJ + IN_COLS) * DM + (size_t)r * 8) = z; }
    for (int i = gtid; i < 4 * (QUP_PAD - QUP) * QLR / 8; i += NGT) { const int l = i / ((QUP_PAD - QUP) * QLR / 8), r = i % ((QUP_PAD - QUP) * QLR / 8); *(u32x4*)(WUQ + ((size_t)l * QUP_PAD + QUP) * QLR + (size_t)r * 8) = z; }
}
struct MoeRow { i32x4 asg; f32x2 gate; };
template <int R, bool B16>
__device__ __forceinline__ void load_rows(f32x4 (&v)[R][4], const void* src, const int (&m)[R], int lane, bool combine, const i32x4* ASG, const f32x2* GATE, const float* YB, const LAS int* sbm) {
#pragma unroll
    for (int r = 0; r < R; ++r) {
        if constexpr (B16) { const u32x2* xr = (const u32x2*)((const bf16_t*)src + (size_t)m[r] * DM) + lane;
#pragma unroll
            for (int j = 0; j < 4; ++j) { const u32x2 w = xr[64 * j]; v[r][j] = (f32x4){bflo(w.x), bfhi(w.x), bflo(w.y), bfhi(w.y)}; } }
        else { const f32x4* xr = (const f32x4*)((const float*)src + (size_t)m[r] * DM) + lane;
#pragma unroll
            for (int j = 0; j < 4; ++j) v[r][j] = xr[64 * j]; } }
    if (combine) {
        i32x4 a[R]; f32x2 g[R]; const int tailrows = sbm[16]  ; const bf16_t* YBb = (const bf16_t*)YB; const bf16_t* YP = YBb + (WS_YP - WS_YB) / 2;
#pragma unroll
        for (int r = 0; r < R; ++r) { a[r] = ASG[m[r]]; g[r] = GATE[m[r]]; }
        f32x4 y0[R][4], y1[R][4];
#pragma unroll
        for (int r = 0; r < R; ++r) { const size_t r0 = (size_t)sbm[a[r].x] * 256 + a[r].y, r1 = (size_t)sbm[a[r].z] * 256 + a[r].w;
            const u32x2* p0 = (const u32x2*)(YBb + r0 * DM) + lane; const u32x2* p1 = (const u32x2*)(YBb + r1 * DM) + lane;
#pragma unroll
            for (int j = 0; j < 4; ++j) { const u32x2 w0 = p0[64 * j], w1 = p1[64 * j]; y0[r][j] = (f32x4){bflo(w0.x), bfhi(w0.x), bflo(w0.y), bfhi(w0.y)}; y1[r][j] = (f32x4){bflo(w1.x), bfhi(w1.x), bflo(w1.y), bfhi(w1.y)}; }
            if (r0 < (size_t)tailrows) { for (int q = 0; q < 3; ++q) { const u32x2* pp = (const u32x2*)(YP + ((size_t)q * 2048 + r0) * DM) + lane;
#pragma unroll
                for (int j = 0; j < 4; ++j) { const u32x2 w = pp[64 * j]; y0[r][j] += (f32x4){bflo(w.x), bfhi(w.x), bflo(w.y), bfhi(w.y)}; } } }
            if (r1 < (size_t)tailrows) { for (int q = 0; q < 3; ++q) { const u32x2* pp = (const u32x2*)(YP + ((size_t)q * 2048 + r1) * DM) + lane;
#pragma unroll
                for (int j = 0; j < 4; ++j) { const u32x2 w = pp[64 * j]; y1[r][j] += (f32x4){bflo(w.x), bfhi(w.x), bflo(w.y), bfhi(w.y)}; } } } }
#pragma unroll
        for (int r = 0; r < R; ++r)
#pragma unroll
            for (int j = 0; j < 4; ++j) v[r][j] = (v[r][j] + g[r].x * y0[r][j]) + g[r].y * y1[r][j];
    }
}
__device__ __forceinline__ float row_ss(const f32x4 (&v)[4]) {
    float s = 0.f;
#pragma unroll
    for (int j = 0; j < 4; ++j) s += (v[j].x * v[j].x + v[j].y * v[j].y) + (v[j].z * v[j].z + v[j].w * v[j].w);
    return s;
}
__device__ __forceinline__ float row_rstd(const f32x4 (&v)[4]) { return 1.0f / sqrtf(wave_sum(row_ss(v)) * (1.0f / DM) + RMS_EPS); }
template <int R, bool B16>
__device__ __forceinline__ void t_norm(const void* src, bf16_t* xdst, float* RS, int gw, int NGW, int lane, bool combine, const i32x4* ASG, const f32x2* GATE, const float* YB, const LAS int* sbm) {
    asm volatile("" : "+v"(lane));
    for (int m0 = gw; m0 < MTOK; m0 += R * NGW) {
        int m[R]; f32x4 v[R][4];
#pragma unroll
        for (int r = 0; r < R; ++r) m[r] = min(m0 + r * NGW, MTOK - 1);
        load_rows<R, B16>(v, src, m, lane, combine, ASG, GATE, YB, sbm);
#pragma unroll
        for (int r = 0; r < R; ++r) {
            const float rstd = row_rstd(v[r]);
            if (m0 + r * NGW < MTOK) {
                if (xdst) { u32x2* xo = (u32x2*)(xdst + (size_t)m[r] * DM) + lane;
#pragma unroll
                    for (int j = 0; j < 4; ++j) { u32x2 w; w.x = cvt_pk_bf16(v[r][j].x, v[r][j].y); w.y = cvt_pk_bf16(v[r][j].z, v[r][j].w); xo[64 * j] = w; } }
                if (lane == 0) RS[m[r]] = rstd;
            }
        }
    }
}
__device__ __forceinline__ void t_rs(const float* SS, float* RS, int bx, int G, int tid) {
    for (int m = bx + G * tid; m < MTOK; m += G * 512) { const f32x4* p = (const f32x4*)(SS + (size_t)m * 16); const f32x4 a = p[0], b = p[1], c = p[2], d = p[3];
        const float sq = (((a.x + a.y) + (a.z + a.w)) + ((b.x + b.y) + (b.z + b.w))) + (((c.x + c.y) + (c.z + c.w)) + ((d.x + d.y) + (d.z + d.w)));
        RS[m] = 1.0f / sqrtf(sq * (1.0f / DM) + RMS_EPS); }
}
template <bool B16>
__device__ __forceinline__ void t_final(const void* src, float* out, const float* gain, int gw, int NGW, int lane, bool combine, const i32x4* ASG, const f32x2* GATE, const float* YB, const LAS int* sbm) {
    asm volatile("" : "+v"(lane));
    constexpr int R = 2;
    f32x4 gg[4];
#pragma unroll
    for (int j = 0; j < 4; ++j) gg[j] = *((const f32x4*)gain + lane + 64 * j);
    for (int m0 = gw; m0 < MTOK; m0 += R * NGW) {
        int m[R]; f32x4 v[R][4];
#pragma unroll
        for (int r = 0; r < R; ++r) m[r] = min(m0 + r * NGW, MTOK - 1);
        load_rows<R, B16>(v, src, m, lane, combine, ASG, GATE, YB, sbm);
#pragma unroll
        for (int r = 0; r < R; ++r) {
            const float rstd = row_rstd(v[r]);
            if (m0 + r * NGW < MTOK) { f32x4* xo = (f32x4*)(out + (size_t)m[r] * DM) + lane;
#pragma unroll
                for (int j = 0; j < 4; ++j) xo[64 * j] = v[r][j] * rstd * gg[j]; }
        }
    }
}
__device__ __forceinline__ void t_mla_prep(const bf16_t* PROJ, const float* gq, const float* gkv, bf16_t* CQN, bf16_t* CKVN, bf16_t* KR, int gw, int NGW, int lane) {
    asm volatile("" : "+v"(lane));
    constexpr int R = 8;
    f32x4 gq0 = {0.f, 0.f, 0.f, 0.f}, gq1 = gq0, gk0 = gq0, gk1 = gq0;
    if (lane < 48) { gq0 = *(const f32x4*)(gq + 8 * lane); gq1 = *(const f32x4*)(gq + 8 * lane + 4); }
    if (lane < 32) { gk0 = *(const f32x4*)(gkv + 8 * lane); gk1 = *(const f32x4*)(gkv + 8 * lane + 4); }
    for (int m0 = gw; m0 < MTOK; m0 += R * NGW) {
        u32x4 a[R], b[R]; unsigned short k1[R], k2[R]; int m[R];
#pragma unroll
        for (int r = 0; r < R; ++r) { m[r] = min(m0 + r * NGW, MTOK - 1); const bf16_t* p = PROJ + (size_t)m[r] * PJ;
            a[r] = (u32x4){0u, 0u, 0u, 0u}; b[r] = a[r]; k1[r] = 0; k2[r] = 0;
            if (lane < 48) a[r] = *(const u32x4*)(p + PC_CQ + 8 * lane);
            if (lane < 32) b[r] = *(const u32x4*)(p + PC_CKV + 8 * lane);
            if (lane < 16) { k1[r] = p[PC_KR + lane]; k2[r] = p[PC_KR + 16 + lane]; } }
#pragma unroll
        for (int r = 0; r < R; ++r) {
            float fa[8], fb[8]; float sa = 0.f, sb = 0.f;
#pragma unroll
            for (int i = 0; i < 4; ++i) { fa[2 * i] = bflo(a[r][i]); fa[2 * i + 1] = bfhi(a[r][i]); fb[2 * i] = bflo(b[r][i]); fb[2 * i + 1] = bfhi(b[r][i]); }
#pragma unroll
            for (int i = 0; i < 8; ++i) { sa += fa[i] * fa[i]; sb += fb[i] * fb[i]; }
            const float ra = 1.0f / sqrtf(wave_sum(sa) * (1.0f / QLR) + RMS_EPS), rb = 1.0f / sqrtf(wave_sum(sb) * (1.0f / KVLR) + RMS_EPS);
            if (m0 + r * NGW < MTOK) {
                if (lane < 48) { u32x4 w;
                    w.x = cvt_pk_bf16(fa[0] * ra * gq0.x, fa[1] * ra * gq0.y); w.y = cvt_pk_bf16(fa[2] * ra * gq0.z, fa[3] * ra * gq0.w); w.z = cvt_pk_bf16(fa[4] * ra * gq1.x, fa[5] * ra * gq1.y); w.w = cvt_pk_bf16(fa[6] * ra * gq1.z, fa[7] * ra * gq1.w);
                    *(u32x4*)(CQN + (size_t)m[r] * QLR + 8 * lane) = w; }
                if (lane < 32) { u32x4 w;
                    w.x = cvt_pk_bf16(fb[0] * rb * gk0.x, fb[1] * rb * gk0.y); w.y = cvt_pk_bf16(fb[2] * rb * gk0.z, fb[3] * rb * gk0.w); w.z = cvt_pk_bf16(fb[4] * rb * gk1.x, fb[5] * rb * gk1.y); w.w = cvt_pk_bf16(fb[6] * rb * gk1.z, fb[7] * rb * gk1.w);
                    *(u32x4*)(CKVN + (size_t)m[r] * KVLR + 8 * lane) = w; }
                if (lane < 16) { const float x1 = bf2f(k1[r]), x2 = bf2f(k2[r]); float c, s; rope_cs(m[r] & (SEQ - 1), lane, c, s);
                    KR[(size_t)m[r] * 32 + lane] = (bf16_t)(cvt_pk_bf16(x1 * c - x2 * s, 0.f) & 0xffffu); KR[(size_t)m[r] * 32 + 16 + lane] = (bf16_t)(cvt_pk_bf16(x1 * s + x2 * c, 0.f) & 0xffffu); }
            }
        }
    }
}
__device__ __forceinline__ void t_mla_prep2(const bf16_t* PROJ, const float* SSL, float* RSQ, float* RSKV, bf16_t* KR, int gw, int NGW, int lane) {
    asm volatile("" : "+v"(lane));
    constexpr int R = 8;
    for (int m0 = gw; m0 < MTOK; m0 += R * NGW) {
        unsigned short k1[R], k2[R]; f32x4 sa[R], sb[R], sc[R]; int m[R];
#pragma unroll
        for (int r = 0; r < R; ++r) { m[r] = min(m0 + r * NGW, MTOK - 1); const bf16_t* p = PROJ + (size_t)m[r] * PJ; k1[r] = 0; k2[r] = 0;
            if (lane < 16) { k1[r] = p[PC_KR + lane]; k2[r] = p[PC_KR + 16 + lane]; }
            const f32x4* sp = (const f32x4*)(SSL + (size_t)m[r] * 16); sa[r] = sp[0]; sb[r] = sp[1]; sc[r] = sp[2]; }
#pragma unroll
        for (int r = 0; r < R; ++r) {
            if (m0 + r * NGW < MTOK) {
                if (lane == 32) { const float sq = ((sa[r].x + sa[r].y) + (sa[r].z + sa[r].w)) + ((sb[r].x + sb[r].y) + (sb[r].z + sb[r].w)), skv = (sc[r].x + sc[r].y) + (sc[r].z + sc[r].w);
                    RSQ[m[r]] = 1.0f / sqrtf(sq * (1.0f / QLR) + RMS_EPS); RSKV[m[r]] = 1.0f / sqrtf(skv * (1.0f / KVLR) + RMS_EPS); }
                if (lane < 16) { const float x1 = bf2f(k1[r]), x2 = bf2f(k2[r]); float c, s_; rope_cs(m[r] & (SEQ - 1), lane, c, s_);
                    KR[(size_t)m[r] * 32 + lane] = (bf16_t)(cvt_pk_bf16(x1 * c - x2 * s_, 0.f) & 0xffffu); KR[(size_t)m[r] * 32 + 16 + lane] = (bf16_t)(cvt_pk_bf16(x1 * s_ + x2 * c, 0.f) & 0xffffu); }
            }
        }
    }
}
__device__ __forceinline__ void t_post_attn(const bf16_t* OA, const f32x2* ML, const bf16_t* YC, const float* ga, const float* gb, const float* gc, bf16_t* YN, int gw, int NGW, int lane) {
    asm volatile("" : "+v"(lane));
    constexpr int R = 4;
    const bool lo = lane < 32;
    f32x4 gg[4];
#pragma unroll
    for (int j = 0; j < 4; ++j) { const int c = 4 * lane + 256 * j; const float* gp = (c < 384) ? (ga + c) : ((c < 768) ? (gb + c - 384) : (gc + c - 768)); gg[j] = *(const f32x4*)gp; }
    for (int m0 = gw; m0 < MTOK; m0 += R * NGW) {
        int m[R]; f32x2 ml[R][3][3]; u32x2 oa[R][3][3]; u32x2 yv[R];
#pragma unroll
        for (int r = 0; r < R; ++r) { m[r] = min(m0 + r * NGW, MTOK - 1);
#pragma unroll
            for (int j = 0; j < 3; ++j) { const int c = 4 * lane + 256 * j; const bool isA = c < 384; const int cp = isA ? c : c - 384, pb = isA ? 0 : 3, h = cp >> 6;
#pragma unroll
                for (int g = 0; g < 3; ++g) { const int part = pb + ((isA || g < 2) ? g : 1);
                    ml[r][j][g] = ML[((size_t)part * MTOK + m[r]) * 8 + h]; oa[r][j][g] = *(const u32x2*)(OA + ((size_t)part * MTOK + m[r]) * 384 + cp); } }
            yv[r] = *(const u32x2*)(YC + (size_t)m[r] * 256 + 4 * lane); }
#pragma unroll
        for (int r = 0; r < R; ++r) {
            f32x4 v[4];
#pragma unroll
            for (int j = 0; j < 3; ++j) {
                const int c = 4 * lane + 256 * j; const bool isA = c < 384;
                const float mx = fmaxf(fmaxf(ml[r][j][0].x, ml[r][j][1].x), ml[r][j][2].x);
                float w[3]; float ws_ = 0.f;
#pragma unroll
                for (int g = 0; g < 3; ++g) { w[g] = (isA || g < 2) ? ml[r][j][g].y * __expf(ml[r][j][g].x - mx) : 0.f; ws_ += w[g]; }
                const float rw = 1.0f / ws_; f32x4 acc = {0.f, 0.f, 0.f, 0.f};
#pragma unroll
                for (int g = 0; g < 3; ++g) { const u32x2 t = oa[r][j][g]; const float wg = w[g] * rw;
                    acc.x += wg * bflo(t.x); acc.y += wg * bfhi(t.x); acc.z += wg * bflo(t.y); acc.w += wg * bfhi(t.y); }
                v[j] = acc;
            }
            { const u32x2 t = yv[r]; v[3] = (f32x4){bflo(t.x), bfhi(t.x), bflo(t.y), bfhi(t.y)}; }
            float ss[4];
#pragma unroll
            for (int j = 0; j < 4; ++j) ss[j] = (v[j].x * v[j].x + v[j].y * v[j].y) + (v[j].z * v[j].z + v[j].w * v[j].w);
            const float sA = wave_sum(ss[0] + (lo ? ss[1] : 0.f)), sB = wave_sum((lo ? 0.f : ss[1]) + ss[2]), sC = wave_sum(ss[3]);
            const float rA = 1.0f / sqrtf(sA * (1.0f / 384.f) + RMS_EPS), rB = 1.0f / sqrtf(sB * (1.0f / 384.f) + RMS_EPS), rC = 1.0f / sqrtf(sC * (1.0f / 256.f) + RMS_EPS);
            if (m0 + r * NGW < MTOK) {
                u32x2* o8 = (u32x2*)(YN + (size_t)m[r] * DM) + lane;
#pragma unroll
                for (int j = 0; j < 4; ++j) { const int c = 4 * lane + 256 * j;
                    const float rr = (c < 384) ? rA : ((c < 768) ? rB : rC);
                    u32x2 w; w.x = cvt_pk_bf16(v[j].x * rr * gg[j].x, v[j].y * rr * gg[j].y); w.y = cvt_pk_bf16(v[j].z * rr * gg[j].z, v[j].w * rr * gg[j].w); o8[64 * j] = w; }
            }
        }
    }
}
__device__ __forceinline__ void t_norm_route(const bf16_t* X, const float* gain, const float* wr, bf16_t* XN, int* BCNT  , i32x4* ASG, f32x2* GATE,
                                             LAS unsigned char* lds, int wave, int lane) {
    asm volatile("" : "+v"(lane));
    LAS int* cntL = (LAS int*)(lds + MISC_OFF + 320);
    f32x4 wq[4][4][2], gg[4];
#pragma unroll
    for (int j = 0; j < 4; ++j) { gg[j] = *((const f32x4*)gain + lane + 64 * j);
#pragma unroll
        for (int i = 0; i < 4; ++i) { const f32x4* wp = (const f32x4*)(wr + (size_t)(4 * lane + 256 * j + i) * 8); wq[j][i][0] = wp[0]; wq[j][i][1] = wp[1]; } }
    for (int batch = blockIdx.x; batch < MTOK / 64; batch += gridDim.x) {
        int my_e0 = 0, my_e1 = 0; float my_g0 = 0.f, my_g1 = 0.f;
#pragma unroll 1
        for (int rg = 0; rg < 2; ++rg) {
        f32x4 xv[4][4];
#pragma unroll
        for (int r4 = 0; r4 < 4; ++r4) { const u32x2* xr = (const u32x2*)(X + (size_t)(batch * 64 + wave * 8 + rg * 4 + r4) * DM) + lane;
#pragma unroll
            for (int j = 0; j < 4; ++j) { const u32x2 w = xr[64 * j]; xv[r4][j] = (f32x4){bflo(w.x), bfhi(w.x), bflo(w.y), bfhi(w.y)}; } }
#pragma unroll
        for (int r4 = 0; r4 < 4; ++r4) {
            const int rr = rg * 4 + r4;
            const int m = batch * 64 + wave * 8 + rr;
            f32x4 v[4];
#pragma unroll
            for (int j = 0; j < 4; ++j) v[j] = xv[r4][j];
            const float rstd = row_rstd(v);
            float lg[8];
#pragma unroll
            for (int e = 0; e < 8; ++e) lg[e] = 0.f;
            u32x2* o8 = (u32x2*)(XN + (size_t)m * DM) + lane;
#pragma unroll
            for (int j = 0; j < 4; ++j) {
                const f32x4 hh = {v[j].x * rstd * gg[j].x, v[j].y * rstd * gg[j].y, v[j].z * rstd * gg[j].z, v[j].w * rstd * gg[j].w};
                u32x2 w; w.x = cvt_pk_bf16(hh.x, hh.y); w.y = cvt_pk_bf16(hh.z, hh.w); o8[64 * j] = w;
#pragma unroll
                for (int i = 0; i < 4; ++i) { const f32x4 w0 = wq[j][i][0], w1 = wq[j][i][1]; const float hv = hh[i];
                    lg[0] += hv * w0.x; lg[1] += hv * w0.y; lg[2] += hv * w0.z; lg[3] += hv * w0.w; lg[4] += hv * w1.x; lg[5] += hv * w1.y; lg[6] += hv * w1.z; lg[7] += hv * w1.w; } }
#pragma unroll
            for (int e = 0; e < 8; ++e) lg[e] = wave_sum(lg[e]);
            int e0 = 0; float l0 = lg[0];
#pragma unroll
            for (int e = 1; e < 8; ++e) if (lg[e] > l0) { l0 = lg[e]; e0 = e; }
            int e1 = -1; float l1 = -3.0e38f;
#pragma unroll
            for (int e = 0; e < 8; ++e) if (e != e0 && lg[e] > l1) { l1 = lg[e]; e1 = e; }
            const float ex = __expf(l1 - l0); const float g0 = 1.0f / (1.0f + ex), g1 = ex * g0;
            if (lane == rr) { my_e0 = e0; my_e1 = e1; my_g0 = g0; my_g1 = g1; }
        }
        }
        const bool valid = lane < 8;
        if (lane < 8) { const int m = batch * 64 + wave * 8 + lane; ASG[m] = (i32x4){my_e0, 0, my_e1, 0}; GATE[m] = (f32x2){my_g0, my_g1}; }
        int c = 0;
#pragma unroll
        for (int e = 0; e < 8; ++e) { const int ce = __popcll(__ballot(valid && my_e0 == e)) + __popcll(__ballot(valid && my_e1 == e)); if (lane == e) c = ce; }
        if (lane < 8) cntL[wave * 8 + lane] = c;
        __syncthreads();
        if (wave == 0 && lane < 8) { int tot = 0;
#pragma unroll
            for (int w = 0; w < 8; ++w) tot += cntL[w * 8 + lane];
            BCNT[batch * 8 + lane] = tot; }
        __syncthreads();
    }
}
__device__ __forceinline__ void t_assign(const int* BCNT, int* TOK, i32x4* ASG, LAS int* cntm, LAS int* sbm, LAS unsigned char* lds, int wave, int lane) {
    LAS int* baseL = (LAS int*)(lds + MISC_OFF + 256);
    constexpr int NB64 = MTOK / 64;
    if (wave == 0) { int tot = 0;
        for (int i = 0; i < NB64 / 8; ++i) tot += BCNT[lane + 64 * i];
        tot += __shfl_xor(tot, 8); tot += __shfl_xor(tot, 16); tot += __shfl_xor(tot, 32);
        if (lane < 8) cntm[lane] = tot; }
    for (int batch = blockIdx.x; batch < NB64; batch += gridDim.x) {
        if (wave == 0) {
            { int base = 0; for (int i = 0; i < NB64 / 8; ++i) { const int v = BCNT[lane + 64 * i]; base += ((lane >> 3) + 8 * i < batch) ? v : 0; }
              base += __shfl_xor(base, 8); base += __shfl_xor(base, 16); base += __shfl_xor(base, 32);
              if (lane < 8) baseL[lane] = base; }
            asm volatile("s_waitcnt lgkmcnt(0)" ::: "memory");
            const int m = batch * 64 + lane; const i32x4 a = ASG[m];
            const unsigned long long lt = (1ull << lane) - 1ull, le = lt | (1ull << lane);
            int rank0 = 0, rank1 = 0;
#pragma unroll
            for (int e = 0; e < 8; ++e) { const unsigned long long m0 = __ballot(a.x == e), m1 = __ballot(a.z == e); const int bs = baseL[e];
                if (a.x == e) rank0 = bs + __popcll(m0 & lt) + __popcll(m1 & lt);
                if (a.z == e) rank1 = bs + __popcll(m0 & le) + __popcll(m1 & lt); }
            TOK[a.x * 16384 + rank0] = m; TOK[a.z * 16384 + rank1] = m;
            ASG[m] = (i32x4){a.x, rank0, a.z, rank1};
        }
    }
    __syncthreads();
    if (threadIdx.x == 0) { int s = 0; for (int e = 0; e < 8; ++e) { sbm[e] = s; s += (cntm[e] + 255) >> 8; } }
    __syncthreads();
}


struct Args { const float* in[21]; float* out; unsigned char* ws; int nsub; int pad; };
#define PH_BEGIN() kptr_t kp_ = kp; GAS unsigned char* ws_ = (GAS unsigned char*)ws; asm volatile("" : "+s"(kp_), "+s"(ws_))
#define INP(i) ((const float*)(*(GAS const float* const __attribute__((address_space(4)))*)(kp_ + 8 * (i))))
#define WSP(T, off) ((T*)(GAS T*)(ws_ + (off)))
enum { I_X = 0, I_GMIX, I_WIN, I_GQ, I_GKV, I_WUQ, I_WUKV, I_RPB, I_GOA, I_GOB, I_GOC, I_WO, I_GFFN, I_W1, I_W3, I_W2, I_WR, I_EW1, I_EW3, I_EW2, I_GFIN };
#define TID ((int)threadIdx.x)
#define LANE ((int)threadIdx.x & 63)
#define GRID_BAR() xcd_barrier(bar)
template <int l> __device__ __forceinline__ void run_layer(const kptr_t kp, unsigned char* const ws, LAS unsigned char* const lds, const XcdBarrier& bar, const int G, const int bx, const int vcu, const int wave, const int nsub) {
    const int gw = vcu * 8 + wave, NGW = G * 8;
    LAS int* sbm = (LAS int*)(lds + MISC_OFF + 64);
    LAS int* cntm = (LAS int*)(lds + MISC_OFF + 96);
    if constexpr (l == 1 || l == 3) { PH_BEGIN(); t_rs(WSP(float, WS_XN)  , WSP(float, WS_RSTD), bx, G, TID); }
    else { PH_BEGIN(); bf16_t* X = WSP(bf16_t, WS_X); const bool pending = (l == 2);
      t_norm<(l == 2) ? 2 : 4, (l != 0)>(l == 0 ? (const void*)INP(I_X) : (const void*)X, (pending || l == 0) ? X : nullptr, WSP(float, WS_RSTD), gw, NGW, LANE, pending, WSP(i32x4, WS_ASG), WSP(f32x2, WS_GATE), WSP(float, WS_YB), sbm); }
    GRID_BAR();
    { PH_BEGIN(); pg8::Gemm g{WSP(bf16_t, WS_X), WSP(bf16_t, WS_WIN) + (size_t)l * PJ * DM, DM, nullptr, 0}; pg8::StaticOrder S; S.init(MTOK, PJ, G, bx);
      pg8::EpiBf16S E{WSP(bf16_t, WS_PROJ), PJ, WSP(float, WS_RSTD), WSP(float, WS_XN + 2 * MiB)  , IN_COLS};
      pg8::gemm_phase<pg8::EpiBf16S, pg8::StaticOrder, true, false>(lds + RING_OFF, g, S, E); }
    GRID_BAR();
    { PH_BEGIN(); t_mla_prep2(WSP(bf16_t, WS_PROJ), WSP(float, WS_XN + 2 * MiB), WSP(float, WS_RSQ), WSP(float, WS_RSKV), WSP(bf16_t, WS_KR), gw, NGW, LANE); }
    GRID_BAR();
    { PH_BEGIN(); pg8::Gemm g{WSP(bf16_t, WS_PROJ) + PC_CQ, WSP(bf16_t, WS_WUQ) + (size_t)l * QUP_PAD * QLR, QLR, nullptr, PJ}; pg8::StaticOrder S; S.init(MTOK, QUP_PAD, G, bx);
      pg8::EpiBf16S E{WSP(bf16_t, WS_QB), QUP_PAD, WSP(float, WS_RSQ), nullptr, QUP};
      pg8::gemm_phase<pg8::EpiBf16S, pg8::StaticOrder, true, false, false, true>(lds + RING_OFF, g, S, E); }
    { PH_BEGIN(); pg8::Gemm g{WSP(bf16_t, WS_PROJ) + PC_CKV, WSP(bf16_t, WS_WUKV) + (size_t)l * KVUP * KVLR, KVLR, nullptr, PJ}; pg8::StaticOrder S; S.init(MTOK, KVUP, G, (bx + G / 2) % G);
      pg8::EpiBf16S E{WSP(bf16_t, WS_KVB), KVUP, WSP(float, WS_RSKV), nullptr, KVUP};
      pg8::gemm_phase<pg8::EpiBf16S, pg8::StaticOrder, true, false, false, true>(lds + RING_OFF, g, S, E); }
    GRID_BAR();
    {
        LAS char* al = (LAS char*)(lds + RING_OFF);
        const int ub0 = (vcu * 768) / G, nb = ((vcu + 1) * 768) / G - ub0, ua0 = (vcu * 1152) / G, na = ((vcu + 1) * 1152) / G - ua0, uc0 = (vcu * 256) / G, nc = ((vcu + 1) * 256) / G - uc0;
#pragma unroll 1
        for (int k = 0; k < nb; ++k) { PH_BEGIN(); const int ub = ub0 + k, grp = ub >> 5, bh = grp >> 1; att::mla_unit(bh / 6, bh % 6, ub & 31, grp & 1, WSP(bf16_t, WS_QB), WSP(bf16_t, WS_KVB), WSP(bf16_t, WS_KR), WSP(bf16_t, WS_OA), WSP(f32x2, WS_ML), al); }
        { PH_BEGIN(); att::dil_phase(ua0, na, WSP(bf16_t, WS_PROJ), WSP(bf16_t, WS_OA), WSP(f32x2, WS_ML), al); }
        { PH_BEGIN(); att::nat_phase(uc0, nc, WSP(bf16_t, WS_PROJ), WSP(bf16_t, WS_Y), INP(I_RPB) + (size_t)l * 4 * 465, al); }
    }
    GRID_BAR();
    { PH_BEGIN(); t_post_attn(WSP(bf16_t, WS_OA), WSP(f32x2, WS_ML), WSP(bf16_t, WS_Y), INP(I_GOA) + l * 384, INP(I_GOB) + l * 384, INP(I_GOC) + l * 256, WSP(bf16_t, WS_YN), gw, NGW, LANE); }
    GRID_BAR();
    { PH_BEGIN(); pg8::Gemm g{WSP(bf16_t, WS_YN), WSP(bf16_t, WS_WO) + (size_t)l * DM * DM, DM, nullptr, 0}; pg8::StaticOrder S; S.init(MTOK, DM, G, bx);
      pg8::EpiResidB E{nullptr, WSP(bf16_t, WS_X), WSP(bf16_t, WS_X), DM, (l & 1) ? nullptr : WSP(float, WS_XN)};
      pg8::gemm_phase<pg8::EpiResidB, pg8::StaticOrder, false, false>(lds + RING_OFF, g, S, E); }
    GRID_BAR();
    if (2 * l + 1 >= nsub) return;
    const int j = l >> 1;
    if constexpr ((l & 1) == 0) {
        { PH_BEGIN(); t_rs(WSP(float, WS_XN), WSP(float, WS_RSTD), bx, G, TID); }
        GRID_BAR();
        { PH_BEGIN(); pg8::Gemm g{WSP(bf16_t, WS_X), WSP(bf16_t, WS_W13) + (size_t)j * 2 * DFF * DM, DM, nullptr, 0}; pg8::StaticOrder S; S.init(MTOK, 2 * DFF, G, bx);
          pg8::EpiSwiGLUS E{WSP(bf16_t, WS_H), DFF, WSP(float, WS_RSTD)};
          pg8::gemm_phase<pg8::EpiSwiGLUS, pg8::StaticOrder, true, false>(lds + RING_OFF, g, S, E); }
        GRID_BAR();
        { PH_BEGIN(); pg8::Gemm g{WSP(bf16_t, WS_H), WSP(bf16_t, WS_W2) + (size_t)j * DM * DFF, DFF, nullptr, 0}; pg8::StaticOrder S; S.init(MTOK, DM, G, bx);
          pg8::EpiResidB E{nullptr, WSP(bf16_t, WS_X), WSP(bf16_t, WS_X), DM, WSP(float, WS_XN)};
          pg8::gemm_phase<pg8::EpiResidB, pg8::StaticOrder, false, false>(lds + RING_OFF, g, S, E); }
        GRID_BAR();
    } else {
        { PH_BEGIN(); t_norm_route(WSP(bf16_t, WS_X), INP(I_GFFN) + l * DM, INP(I_WR) + (size_t)j * DM * 8, WSP(bf16_t, WS_XN), WSP(int, WS_CTL) + CW_CUR + j * 2048, WSP(i32x4, WS_ASG), WSP(f32x2, WS_GATE), lds, wave, LANE); }
        GRID_BAR();
        { PH_BEGIN(); t_assign(WSP(int, WS_CTL) + CW_CUR + j * 2048, WSP(int, WS_TOK) + (size_t)j * 8 * 16384, WSP(i32x4, WS_ASG), cntm, sbm, lds, wave, LANE); }
        GRID_BAR();
        const int NBm = sbm[7] + ((cntm[7] + 255) >> 8);
        { PH_BEGIN(); pg8::Gemm g{WSP(bf16_t, WS_XN), WSP(bf16_t, WS_EW13) + (size_t)j * 8 * 2 * DFFE * DM, DM, WSP(int, WS_TOK) + (size_t)j * 8 * 16384, 0}; pg8::MoeOrder S; S.init(cntm, 2 * DFFE, G, bx);
          pg8::EpiSwiGLU E{WSP(bf16_t, WS_H), DFFE};
          pg8::gemm_phase<pg8::EpiSwiGLU, pg8::MoeOrder, true, true>(lds + RING_OFF, g, S, E); }
        GRID_BAR();
        int pm0 = (((4 * NBm) % G) + 3) >> 2; if (pm0 > 8) pm0 = 0;
        if (TID == 0) sbm[16] = pm0 * 256;
        { PH_BEGIN(); pg8::Gemm g{WSP(bf16_t, WS_H), WSP(bf16_t, WS_EW2) + (size_t)j * 8 * DM * DFFE, DFFE, nullptr, 0}; pg8::MoeOrder S; S.init(cntm, DM, G, bx); S.skip_rows(pm0);
          pg8::EpiBf16 E{WSP(bf16_t, WS_YB), DM};
          pg8::gemm_phase<pg8::EpiBf16, pg8::MoeOrder, true, false>(lds + RING_OFF, g, S, E); }
        if (pm0 > 0) { PH_BEGIN(); pg8::Gemm g{WSP(bf16_t, WS_H), WSP(bf16_t, WS_EW2) + (size_t)j * 8 * DM * DFFE, DFFE / 4, nullptr, DFFE}; pg8::MoeTailOrder S; S.init(cntm, DM, G, bx, pm0);
          pg8::EpiQuarter E{WSP(bf16_t, WS_YB), WSP(bf16_t, WS_YP), (size_t)2048 * DM, DM};
          pg8::gemm_phase<pg8::EpiQuarter, pg8::MoeTailOrder, true, false, true>(lds + RING_OFF, g, S, E); }
        GRID_BAR();
    }
}
__global__ void __launch_bounds__(512, 2) mega_fwd(Args args) {
    extern __shared__ __attribute__((aligned(16))) unsigned char lds_[];
    LAS unsigned char* lds = (LAS unsigned char*)lds_;
    volatile LAS unsigned* MISC = (volatile LAS unsigned*)(lds + MISC_OFF);
    const int wave = __builtin_amdgcn_readfirstlane((int)threadIdx.x >> 6);
    const int G = gridDim.x, bx = blockIdx.x, vcu = (G % 8 == 0) ? (bx % 8) * (G / 8) + bx / 8 : bx;
    const int gw = vcu * 8 + wave, NGW = G * 8;
    const kptr_t kp = (kptr_t)__builtin_amdgcn_kernarg_segment_ptr();
    unsigned char* const ws = *(unsigned char* const __attribute__((address_space(4)))*)(kp + 176);
    const int nsub = *(const int __attribute__((address_space(4)))*)(kp + 184);
    LAS int* sbm = (LAS int*)(lds + MISC_OFF + 64);

    for (int u = TID; u < 192; u += 512) ((LAS unsigned*)(lds + MISC_OFF))[u] = 0u;
    __syncthreads();
    XcdBarrier bar = xcd_barrier_post((unsigned*)(ws + WS_CTL) + CW_BAR, MISC + 8);

    { PH_BEGIN(); p_prologue(kp_, ws_, lds, gw, NGW, wave, LANE, bx * 512 + TID, G * 512); }
    GRID_BAR();

    if (nsub > 0) run_layer<0>(kp, ws, lds, bar, G, bx, vcu, wave, nsub);
    if (nsub > 2) run_layer<1>(kp, ws, lds, bar, G, bx, vcu, wave, nsub);
    if (nsub > 4) run_layer<2>(kp, ws, lds, bar, G, bx, vcu, wave, nsub);
    if (nsub > 6) run_layer<3>(kp, ws, lds, bar, G, bx, vcu, wave, nsub);
    { PH_BEGIN(); float* out = (float*)(*(GAS float* const __attribute__((address_space(4)))*)(kp_ + 168));
      const bool pending = (nsub == 4 || nsub == 8);
      if (nsub == 0) t_final<false>(INP(I_X), out, INP(I_GFIN), gw, NGW, LANE, pending, WSP(i32x4, WS_ASG), WSP(f32x2, WS_GATE), WSP(float, WS_YB), sbm);
      else t_final<true>(WSP(bf16_t, WS_X), out, INP(I_GFIN), gw, NGW, LANE, pending, WSP(i32x4, WS_ASG), WSP(f32x2, WS_GATE), WSP(float, WS_YB), sbm); }
}

extern "C" void kernel_launch(void* const* d_in, const int* in_sizes, int n_in, void* d_out, int out_size, void* d_ws, size_t ws_size, hipStream_t stream) {
    static int grid = 0;
    if (grid == 0) {
        if (n_in != 21 || in_sizes[0] != MTOK * DM || out_size != MTOK * DM || ws_size < WS_END) {
            fprintf(stderr, "kernel_launch: built for 21 inputs, x/out of %d floats, >= %zu bytes of workspace; got n_in %d, in0 %d, out %d, ws %zu; nothing launched\n", MTOK * DM, (size_t)WS_END, n_in, n_in > 0 ? in_sizes[0] : -1, out_size, ws_size); grid = -1; return; }
        int dev = 0, cus = 0, per_cu = 0;
        if (hipGetDevice(&dev) != hipSuccess || hipDeviceGetAttribute(&cus, hipDeviceAttributeMultiprocessorCount, dev) != hipSuccess) { fprintf(stderr, "kernel_launch: device query failed\n"); grid = -1; return; }
        if (hipFuncSetAttribute((const void*)mega_fwd, hipFuncAttributeMaxDynamicSharedMemorySize, LDS_BYTES) != hipSuccess) { fprintf(stderr, "kernel_launch: hipFuncSetAttribute failed\n"); grid = -1; return; }
        if (hipOccupancyMaxActiveBlocksPerMultiprocessor(&per_cu, (const void*)mega_fwd, 512, LDS_BYTES) != hipSuccess || per_cu < 1)
            fprintf(stderr, "kernel_launch: note: occupancy query reports %d workgroups per CU\n", per_cu);
        (void)hipGetLastError();
        grid = cus;
    }
    if (grid < 0) return;
    if (hipMemsetAsync((char*)d_ws + WS_CTL, 0, CTL_ZERO_BYTES, stream) != hipSuccess) { fprintf(stderr, "kernel_launch: memset failed\n"); return; }
    Args a{};
    for (int i = 0; i < 21; ++i) a.in[i] = (const float*)d_in[i];
    a.out = (float*)d_out; a.ws = (unsigned char*)d_ws; a.nsub = DBG_NSUB; a.pad = 0;
    hipLaunchKernelGGL(mega_fwd, dim3(grid), dim3(512), LDS_BYTES, stream, a);
    const hipError_t le = hipPeekAtLastError();
    if (le != hipSuccess) fprintf(stderr, "kernel_launch: launch failed: %s\n", hipGetErrorName(le));
}
```

```cpp
#include <hip/hip_runtime.h>
#include <cstdio>
#include <cstdint>

#ifndef DBG_NSUB
#define DBG_NSUB 8
#endif

#define GAS __attribute__((address_space(1)))
#define LAS __attribute__((address_space(3)))
typedef unsigned short bf16_t;
typedef short bf16x8 __attribute__((ext_vector_type(8)));
typedef short s16x4 __attribute__((ext_vector_type(4)));
typedef float f32x2 __attribute__((ext_vector_type(2)));
typedef float f32x4 __attribute__((ext_vector_type(4)));
typedef float f32x16 __attribute__((ext_vector_type(16)));
typedef unsigned u32x2 __attribute__((ext_vector_type(2)));
typedef unsigned u32x4 __attribute__((ext_vector_type(4)));
typedef int i32x4 __attribute__((ext_vector_type(4)));

constexpr int DM = 1024, SEQ = 8192, MTOK = 16384, DEPTH = 4;
constexpr int PJ = 2816;
constexpr int PC_QA = 0, PC_KA = 384, PC_VA = 768, PC_CQ = 1152, PC_CKV = 1536, PC_QC = 1792, PC_KC = 2048, PC_VC = 2304, PC_KR = 2560;
constexpr int IN_COLS = 2592, QLR = 384, KVLR = 256, QUP = 576, QUP_PAD = 768, KVUP = 768;
constexpr int DFF = 2816, DFFE = 3584, NEXP = 8;
constexpr int MOE_ROWS = 34816;
constexpr float RMS_EPS = 1e-6f;

constexpr size_t MiB = 1u << 20;
constexpr size_t WS_CTL = 0, CTL_ZERO_BYTES = 2 * MiB;
constexpr size_t WS_TOK = 1 * MiB;
constexpr size_t WS_RSQ = 320 * 1024, WS_RSKV = 384 * 1024;
constexpr size_t WS_RSTD = 256 * 1024;
constexpr size_t WS_WIN = 4 * MiB, WS_WUQ = 26 * MiB, WS_WUKV = 29 * MiB, WS_WO = 31 * MiB, WS_W13 = 39 * MiB, WS_W2 = 61 * MiB, WS_EW13 = 72 * MiB, WS_EW2 = 296 * MiB;
constexpr size_t WS_X = 408 * MiB, WS_XN = 472 * MiB;
constexpr size_t WS_PROJ = 504 * MiB, WS_YN = 504 * MiB  , WS_CQN = 592 * MiB, WS_CKVN = 604 * MiB, WS_KR = 612 * MiB,
                 WS_QB = 613 * MiB, WS_KVB = 637 * MiB, WS_OA = 661 * MiB  , WS_Y = 721 * MiB  , WS_ML = 729 * MiB  ;
constexpr size_t WS_H = 504 * MiB;
constexpr size_t WS_YB = 742 * MiB, WS_ASG = 878 * MiB, WS_GATE = 878 * MiB + 512 * 1024, WS_YP = 880 * MiB  , WS_END = 892 * MiB;
static_assert(WS_WIN + (size_t)4 * PJ * DM * 2 <= WS_WUQ && WS_WUQ + (size_t)4 * QUP_PAD * QLR * 2 <= WS_WUKV && WS_WUKV + (size_t)4 * KVUP * KVLR * 2 <= WS_WO, "ws map 1");
static_assert(WS_WO + (size_t)4 * DM * DM * 2 <= WS_W13 && WS_W13 + (size_t)2 * 2 * DFF * DM * 2 <= WS_W2 && WS_W2 + (size_t)2 * DM * DFF * 2 <= WS_EW13, "ws map 2");
static_assert(WS_EW13 + (size_t)16 * 2 * DFFE * DM * 2 <= WS_EW2 && WS_EW2 + (size_t)16 * DM * DFFE * 2 <= WS_X && WS_X + (size_t)MTOK * DM * 4 <= WS_XN && WS_XN + (size_t)MTOK * DM * 2 <= WS_PROJ, "ws map 3");
static_assert(WS_PROJ + (size_t)MTOK * PJ * 2 <= WS_CQN && WS_CQN + (size_t)MTOK * QLR * 2 <= WS_CKVN && WS_CKVN + (size_t)MTOK * KVLR * 2 <= WS_KR && WS_KR + (size_t)MTOK * 32 * 2 <= WS_QB, "ws map 4");
static_assert(WS_QB + (size_t)MTOK * 768 * 2 <= WS_KVB && WS_KVB + (size_t)MTOK * 768 * 2 <= WS_OA && WS_OA + (size_t)5 * MTOK * 384 * 2 <= WS_Y && WS_Y + (size_t)MTOK * 256 * 2 <= WS_ML && WS_ML + (size_t)5 * MTOK * 8 * 8 <= WS_YB, "ws map 5");
static_assert(WS_H + (size_t)MOE_ROWS * DFFE * 2 <= WS_YB && WS_YB + (size_t)MOE_ROWS * DM * 4 <= WS_ASG && WS_GATE + (size_t)MTOK * 8 <= WS_END, "ws map 6");
constexpr int CW_TMO = 0, CW_BAR = 4096, CW_CUR = 8192  ;

#define LDS_WAIT() asm volatile("s_waitcnt lgkmcnt(0)" ::: "memory")
#define SBAR() __builtin_amdgcn_sched_barrier(0)
__device__ __forceinline__ unsigned cvt_pk_bf16(float lo, float hi) { unsigned r; asm volatile("v_cvt_pk_bf16_f32 %0, %1, %2" : "=v"(r) : "v"(lo), "v"(hi)); return r; }
__device__ __forceinline__ float bf2f(unsigned short b) { return __builtin_bit_cast(float, (unsigned)b << 16); }
__device__ __forceinline__ float bflo(unsigned w) { return __builtin_bit_cast(float, w << 16); }
__device__ __forceinline__ float bfhi(unsigned w) { return __builtin_bit_cast(float, w & 0xffff0000u); }
__device__ __forceinline__ float wave_sum(float v) {
#pragma unroll
    for (int o = 1; o < 64; o <<= 1) v += __shfl_xor(v, o);
    return v;
}
__device__ __forceinline__ void rope_cs(int pos, int j, float& c, float& s) {
    const float inv = exp2f(-(float)j * 0.83048202372184058696f);
    const float ang = (float)pos * inv;
    const double rev = (double)ang * 0.15915494309189533577;
    const float fr = (float)(rev - floor(rev));
    s = __builtin_amdgcn_sinf(fr); c = __builtin_amdgcn_cosf(fr);
}

namespace pg8 {
constexpr int BM = 256, BK = 64, HALF = 128, HTB = HALF * BK * 2, STAGE_BYTES = 8 * HTB, NXCD = 8, WGM = 8;
__host__ __device__ __forceinline__ int lds_byte(int r, int c) { const int st = (r >> 4) * 2 + (c >> 5), rr = r & 15, cc = c & 31, ob = rr * 64 + cc * 2; return st * 1024 + (ob ^ (((ob >> 9) & 1) << 5)); }
__host__ __device__ __forceinline__ void stage_rc(int b, int& R, int& C) { const int st = b / 1024, sb = b % 1024, swz = sb ^ (((sb >> 9) & 1) << 5); R = (st >> 1) * 16 + swz / 64; C = (st & 1) * 32 + (swz % 64) / 2; }
__host__ __device__ __forceinline__ int perm32(int rho) { const int n = rho >> 4, i = rho & 15; return 8 * (i >> 2) + 4 * n + (i & 3); }

struct Unit { int pm, pn, pnb, ar0, kc; };
struct Gemm { const bf16_t* A; const bf16_t* Bt; int K; const int* rowtab; int ld; };

struct StaticOrder {
    int nM, nN, nwg, G, c;
    __device__ void init(int M, int N, int G_, int c_) { nM = M / BM; nN = N / BM; nwg = nM * nN; G = G_; c = c_; }
    __device__ bool next(int i, Unit& u) const {
        const long L = (long)i * G + c; if (L >= nwg) return false;
        int wgid = (int)L; { const int q = nwg / NXCD, r = nwg % NXCD, xcd = wgid % NXCD, off = wgid / NXCD; wgid = (xcd < r ? xcd * (q + 1) : r * (q + 1) + (xcd - r) * q) + off; }
        const int nig = WGM * nN, gid = wgid / nig, fm = gid * WGM, gsz = (nM - fm) < WGM ? (nM - fm) : WGM;
        u.pm = fm + ((wgid % nig) % gsz); u.pn = (wgid % nig) / gsz; u.pnb = u.pn; u.ar0 = 0; u.kc = 0; return true;
    }
};
struct MoeOrder {
    StaticOrder so; int sb[9]; int rb0;
    __device__ void init(const LAS int* cnt, int N, int G_, int c_) {
        int s = 0;
#pragma unroll
        for (int e = 0; e < 8; ++e) { sb[e] = s; s += (cnt[e] + 255) >> 8; }
        sb[8] = s; so.nM = s; so.nN = N / BM; so.nwg = s * so.nN; so.G = G_; so.c = c_; rb0 = 0;
    }
    __device__ bool next(int i, Unit& u) const {
        if (!so.next(i, u)) return false;
        u.pm += rb0;
        int e = 0;
#pragma unroll
        for (int j = 1; j < 8; ++j) e += (u.pm >= sb[j]) ? 1 : 0;
        int sbe = sb[0];
#pragma unroll
        for (int j = 1; j < 8; ++j) sbe = (e == j) ? sb[j] : sbe;
        u.pnb = e * so.nN + u.pn; u.ar0 = e * 16384 + (u.pm - sbe) * 256; return true;
    }
    __device__ void skip_rows(int pm0) { so.nM -= pm0; so.nwg = so.nM * so.nN; rb0 = pm0; }
};
struct MoeTailOrder {
    MoeOrder mo; int nsub_;
    __device__ void init(const LAS int* cnt, int N, int G_, int c_, int pm0) { mo.init(cnt, N, G_, c_); nsub_ = pm0 * 16; }
    __device__ bool next(int i, Unit& u) const {
        const int idx = i * mo.so.G + mo.so.c; if (idx >= nsub_) return false;
        const int t = idx >> 2; u.pm = t >> 2; u.pn = t & 3; u.kc = idx & 3;
        int e = 0;
#pragma unroll
        for (int j = 1; j < 8; ++j) e += (u.pm >= mo.sb[j]) ? 1 : 0;
        u.pnb = e * mo.so.nN + u.pn; u.ar0 = 0; return true;
    }
};

struct EpiBf16 {
    static constexpr bool PERM = true, SCALE = false;
    bf16_t* O; int ldc;
    __device__ __forceinline__ void operator()(const f32x4 (&acc)[2][2][4][2], const Unit& u, int wr, int wc, int fr, int fq) const {
        const int row0 = u.pm * BM + wr * 64 + fr, col0 = u.pn * BM + wc * 32 + 8 * fq;
#pragma unroll
        for (int ai = 0; ai < 2; ++ai)
#pragma unroll
            for (int m = 0; m < 4; ++m) { bf16_t* rowp = O + (size_t)(row0 + ai * HALF + m * 16) * ldc + col0;
#pragma unroll
                for (int bj = 0; bj < 2; ++bj) { const f32x4 v0 = acc[ai][bj][m][0], v1 = acc[ai][bj][m][1];
                    u32x4 w; w.x = cvt_pk_bf16(v0[0], v0[1]); w.y = cvt_pk_bf16(v0[2], v0[3]); w.z = cvt_pk_bf16(v1[0], v1[1]); w.w = cvt_pk_bf16(v1[2], v1[3]);
                    *(u32x4*)(rowp + bj * HALF) = w; } }
    }
};
struct EpiBf16S {
    static constexpr bool PERM = true, SCALE = true;
    bf16_t* O; int ldc; const float* rs; float* SSL;
    __device__ __forceinline__ void pre(const Unit& u, int wr, int fr, float (&rsv)[8]) const {
#pragma unroll
        for (int i = 0; i < 8; ++i) rsv[i] = rs[u.pm * BM + wr * 64 + fr + (i >> 2) * HALF + (i & 3) * 16]; }
    __device__ __forceinline__ void operator()(const f32x4 (&acc)[2][2][4][2], const Unit& u, int wr, int wc, int fr, int fq, const float (&rsv)[8]) const {
        const int row0 = u.pm * BM + wr * 64 + fr, col0 = u.pn * BM + wc * 32 + 8 * fq;
        const bool lat = SSL != nullptr && u.pn >= 4 && u.pn <= 6;
#pragma unroll
        for (int ai = 0; ai < 2; ++ai)
#pragma unroll
            for (int m = 0; m < 4; ++m) { const int row = row0 + ai * HALF + m * 16; bf16_t* rowp = O + (size_t)row * ldc + col0; const float r = rsv[ai * 4 + m]; float ss = 0.f;
#pragma unroll
                for (int bj = 0; bj < 2; ++bj) { const f32x4 v0 = acc[ai][bj][m][0] * r, v1 = acc[ai][bj][m][1] * r;
                    if (bj == 1 || u.pn != 4) ss += ((v0[0] * v0[0] + v0[1] * v0[1]) + (v0[2] * v0[2] + v0[3] * v0[3])) + ((v1[0] * v1[0] + v1[1] * v1[1]) + (v1[2] * v1[2] + v1[3] * v1[3]));
                    u32x4 w; w.x = cvt_pk_bf16(v0[0], v0[1]); w.y = cvt_pk_bf16(v0[2], v0[3]); w.z = cvt_pk_bf16(v1[0], v1[1]); w.w = cvt_pk_bf16(v1[2], v1[3]);
                    *(u32x4*)(rowp + bj * HALF) = w; }
                if (lat) { ss += __shfl_xor(ss, 16); ss += __shfl_xor(ss, 32);
                    if (fq == 0) SSL[(size_t)row * 16 + (u.pn - 4) * 4 + wc] = ss; } }
    }
};
struct EpiSwiGLU {
    static constexpr bool PERM = true, SCALE = false;
    bf16_t* O; int ldc;
    __device__ __forceinline__ void operator()(const f32x4 (&acc)[2][2][4][2], const Unit& u, int wr, int wc, int fr, int fq) const {
        const int row0 = u.pm * BM + wr * 64 + fr, col0 = u.pn * (BM / 2) + wc * 16 + 4 * fq;
#pragma unroll
        for (int ai = 0; ai < 2; ++ai)
#pragma unroll
            for (int m = 0; m < 4; ++m) { bf16_t* rowp = O + (size_t)(row0 + ai * HALF + m * 16) * ldc + col0;
#pragma unroll
                for (int bj = 0; bj < 2; ++bj) { const f32x4 a = acc[ai][bj][m][0], b = acc[ai][bj][m][1]; float h[4];
#pragma unroll
                    for (int i = 0; i < 4; ++i) h[i] = a[i] * __builtin_amdgcn_rcpf(1.0f + __builtin_amdgcn_exp2f(-1.4426950408889634f * a[i])) * b[i];
                    u32x2 w; w.x = cvt_pk_bf16(h[0], h[1]); w.y = cvt_pk_bf16(h[2], h[3]);
                    *(u32x2*)(rowp + bj * (HALF / 2)) = w; } }
    }
};
struct EpiSwiGLUS {
    static constexpr bool PERM = true, SCALE = true;
    bf16_t* O; int ldc; const float* rs;
    __device__ __forceinline__ void pre(const Unit& u, int wr, int fr, float (&rsv)[8]) const {
#pragma unroll
        for (int i = 0; i < 8; ++i) rsv[i] = rs[u.pm * BM + wr * 64 + fr + (i >> 2) * HALF + (i & 3) * 16]; }
    __device__ __forceinline__ void operator()(const f32x4 (&acc)[2][2][4][2], const Unit& u, int wr, int wc, int fr, int fq, const float (&rsv)[8]) const {
        const int row0 = u.pm * BM + wr * 64 + fr, col0 = u.pn * (BM / 2) + wc * 16 + 4 * fq;
#pragma unroll
        for (int ai = 0; ai < 2; ++ai)
#pragma unroll
            for (int m = 0; m < 4; ++m) { bf16_t* rowp = O + (size_t)(row0 + ai * HALF + m * 16) * ldc + col0; const float r = rsv[ai * 4 + m];
#pragma unroll
                for (int bj = 0; bj < 2; ++bj) { const f32x4 a = acc[ai][bj][m][0] * r, b = acc[ai][bj][m][1] * r; float h[4];
#pragma unroll
                    for (int i = 0; i < 4; ++i) h[i] = a[i] * __builtin_amdgcn_rcpf(1.0f + __builtin_amdgcn_exp2f(-1.4426950408889634f * a[i])) * b[i];
                    u32x2 w; w.x = cvt_pk_bf16(h[0], h[1]); w.y = cvt_pk_bf16(h[2], h[3]);
                    *(u32x2*)(rowp + bj * (HALF / 2)) = w; } }
    }
};
struct EpiResid {
    static constexpr bool PERM = false, SCALE = false;
    const float* src; float* out; int ldc;
    __device__ __forceinline__ void operator()(const f32x4 (&acc)[2][2][4][2], const Unit& u, int wr, int wc, int fr, int fq) const {
        const int row0 = u.pm * BM + wr * 64 + fr, col0 = u.pn * BM + wc * 32 + 4 * fq;
#pragma unroll
        for (int ai = 0; ai < 2; ++ai)
#pragma unroll
            for (int m = 0; m < 4; ++m) { const size_t off = (size_t)(row0 + ai * HALF + m * 16) * ldc + col0;
#pragma unroll
                for (int bj = 0; bj < 2; ++bj)
#pragma unroll
                    for (int n = 0; n < 2; ++n) { f32x4 v = acc[ai][bj][m][n]; if (src) v += *(const f32x4*)(src + off + bj * HALF + n * 16); *(f32x4*)(out + off + bj * HALF + n * 16) = v; } }
    }
};

struct EpiResidB {
    static constexpr bool PERM = true, SCALE = false;
    const float* src32; const bf16_t* src16; bf16_t* out; int ldc; float* SS;
    __device__ __forceinline__ void operator()(const f32x4 (&acc)[2][2][4][2], const Unit& u, int wr, int wc, int fr, int fq) const {
        const int row0 = u.pm * BM + wr * 64 + fr, col0 = u.pn * BM + wc * 32 + 8 * fq;
#pragma unroll
        for (int ai = 0; ai < 2; ++ai)
#pragma unroll
            for (int m = 0; m < 4; ++m) { const int row = row0 + ai * HALF + m * 16; const size_t off = (size_t)row * ldc + col0; float ss = 0.f;
#pragma unroll
                for (int bj = 0; bj < 2; ++bj) { f32x4 v0 = acc[ai][bj][m][0], v1 = acc[ai][bj][m][1];
                    if (src32) { v0 += *(const f32x4*)(src32 + off + bj * HALF); v1 += *(const f32x4*)(src32 + off + bj * HALF + 4); }
                    else { const u32x4 x = *(const u32x4*)(src16 + off + bj * HALF);
                        v0 += (f32x4){bflo(x.x), bfhi(x.x), bflo(x.y), bfhi(x.y)}; v1 += (f32x4){bflo(x.z), bfhi(x.z), bflo(x.w), bfhi(x.w)}; }
                    ss += ((v0[0] * v0[0] + v0[1] * v0[1]) + (v0[2] * v0[2] + v0[3] * v0[3])) + ((v1[0] * v1[0] + v1[1] * v1[1]) + (v1[2] * v1[2] + v1[3] * v1[3]));
                    u32x4 w; w.x = cvt_pk_bf16(v0[0], v0[1]); w.y = cvt_pk_bf16(v0[2], v0[3]); w.z = cvt_pk_bf16(v1[0], v1[1]); w.w = cvt_pk_bf16(v1[2], v1[3]);
                    *(u32x4*)(out + off + bj * HALF) = w; }
                if (SS) { ss += __shfl_xor(ss, 16); ss += __shfl_xor(ss, 32);
                    if (fq == 0) SS[(size_t)row * 16 + u.pn * 4 + wc] = ss; } }
    }
};
struct EpiQuarter {
    static constexpr bool PERM = false, SCALE = false;
    bf16_t* out0; bf16_t* outq; size_t qstride; int ldc;
    __device__ __forceinline__ void operator()(const f32x4 (&acc)[2][2][4][2], const Unit& u, int wr, int wc, int fr, int fq) const {
        const int row0 = u.pm * BM + wr * 64 + fr, col0 = u.pn * BM + wc * 32 + 4 * fq;
        bf16_t* out = u.kc == 0 ? out0 : outq + (size_t)(u.kc - 1) * qstride;
#pragma unroll
        for (int ai = 0; ai < 2; ++ai)
#pragma unroll
            for (int m = 0; m < 4; ++m) { const size_t off = (size_t)(row0 + ai * HALF + m * 16) * ldc + col0;
#pragma unroll
                for (int bj = 0; bj < 2; ++bj)
#pragma unroll
                    for (int n = 0; n < 2; ++n) { const f32x4 a = acc[ai][bj][m][n]; u32x2 w; w.x = cvt_pk_bf16(a.x, a.y); w.y = cvt_pk_bf16(a.z, a.w); *(u32x2*)(out + off + bj * HALF + n * 16) = w; } }
    }
};

template <class Epi, class Sched, bool ALIGN_EPI, bool GATHER, bool KSPLIT = false, bool APITCH = false>
__device__ __forceinline__ void gemm_phase(LAS unsigned char* lds, const Gemm g, const Sched& S, const Epi& E) {
    int tid = threadIdx.x; asm volatile("" : "+v"(tid));
    const int wid = __builtin_amdgcn_readfirstlane(tid >> 6), lane = tid & 63, wr = wid >> 2, wc = wid & 3, fr = lane & 15, fq = lane >> 4;
    const int K = g.K, nt = K / BK, LDA = (KSPLIT || APITCH) ? g.ld : K, LDB = KSPLIT ? g.ld : K;
    unsigned voffA[2], voffB[2]; unsigned CA2[2];
#pragma unroll
    for (int i = 0; i < 2; ++i) { int R, C; stage_rc(tid * 16 + i * 8192, R, C); const int Rb = Epi::PERM ? ((R & ~31) + perm32(R & 31)) : R;
        voffA[i] = (unsigned)(R * LDA + C) * 2u; voffB[i] = (unsigned)(Rb * LDB + C) * 2u; CA2[i] = (unsigned)C * 2u; }
    const size_t kstep = (size_t)(BK * 2);
    const size_t hstepA = (size_t)HALF * LDA * 2, hstepB = (size_t)HALF * LDB * 2;
    const size_t tstepA = 2 * hstepA, tstepB = 2 * hstepB;
    const unsigned ldsw = (unsigned)wid * 1024u;
    const int aoff = lds_byte(wr * 64 + fr, fq * 8), boff = lds_byte(wc * 32 + fr, fq * 8);
#define PG8_SA(b, h) (((b) * 2 + (h)) * HTB)
#define PG8_SB(b, h) ((4 + (b) * 2 + (h)) * HTB)
#define PG8_STAGE(bufoff, gbase, voff) do { _Pragma("unroll") for (int _i = 0; _i < 2; ++_i) \
        __builtin_amdgcn_global_load_lds((const unsigned*)((const char*)(gbase) + (voff)[_i]), (LAS unsigned*)(lds + (bufoff) + ldsw + _i * 8192), 16, 0, 0); } while (0)
#define PG8_LDA(dst, b, h) do { _Pragma("unroll") for (int m = 0; m < 4; ++m) _Pragma("unroll") for (int k = 0; k < 2; ++k) dst[m][k] = *(const LAS bf16x8*)(lds + PG8_SA(b, h) + aoff + m * 2048 + k * 1024); } while (0)
#define PG8_LDB(dst, b, h) do { _Pragma("unroll") for (int n = 0; n < 2; ++n) _Pragma("unroll") for (int k = 0; k < 2; ++k) dst[n][k] = *(const LAS bf16x8*)(lds + PG8_SB(b, h) + boff + n * 2048 + k * 1024); } while (0)
#define PG8_MMA(ai, bj, At, Bt) do { __builtin_amdgcn_s_setprio(1); _Pragma("unroll") for (int m = 0; m < 4; ++m) _Pragma("unroll") for (int n = 0; n < 2; ++n) _Pragma("unroll") for (int k = 0; k < 2; ++k) \
        acc[ai][bj][m][n] = __builtin_amdgcn_mfma_f32_16x16x32_bf16(Bt[n][k], At[m][k], acc[ai][bj][m][n], 0, 0, 0); __builtin_amdgcn_s_setprio(0); } while (0)
#define PG8_WAIT_V(n) asm volatile("s_waitcnt vmcnt(" #n ")" ::: "memory")
#define PG8_WAIT_L(n) asm volatile("s_waitcnt lgkmcnt(" #n ")" ::: "memory")
#define PG8_BAR __builtin_amdgcn_s_barrier()
#define PG8_STAGE_A(buf, h, p, usenext) do { if constexpr (GATHER) { const unsigned _t = (usenext) ? tkn[h] : tkc[h]; unsigned _v[2]; _v[0] = (_t & 0xffffu) * rowb + CA2[0]; _v[1] = (_t >> 16) * rowb + CA2[1]; PG8_STAGE(PG8_SA(buf, h), p, _v); } \
        else { PG8_STAGE(PG8_SA(buf, h), (p) + (h) * hstepA, voffA); } } while (0)
    Unit cur, nxt; int ui = 0;
    if (!S.next(0, cur)) return;
    f32x4 acc[2][2][4][2];
#pragma unroll
    for (int a = 0; a < 2; ++a)
#pragma unroll
        for (int b = 0; b < 2; ++b)
#pragma unroll
            for (int m = 0; m < 4; ++m)
#pragma unroll
                for (int n = 0; n < 2; ++n) acc[a][b][m][n] = (f32x4){0.f, 0.f, 0.f, 0.f};
    bf16x8 At[4][2], B0[2][2], B1[2][2];
    unsigned tkc[2], tkn[2];
    const unsigned rowb = (unsigned)LDA * 2u;
#define PG8_TOKS(dst, u_) do { int _R0, _R1, _C; stage_rc(tid * 16, _R0, _C); stage_rc(tid * 16 + 8192, _R1, _C); _Pragma("unroll") for (int h = 0; h < 2; ++h) dst[h] = (unsigned)g.rowtab[(u_).ar0 + h * HALF + _R0] | ((unsigned)g.rowtab[(u_).ar0 + h * HALF + _R1] << 16); } while (0)
    if constexpr (GATHER) {
        PG8_TOKS(tkc, cur); tkn[0] = 0u; tkn[1] = 0u;
        Unit n1; if (S.next(1, n1)) PG8_TOKS(tkn, n1);
    }
    const char* cA = GATHER ? (const char*)g.A : (const char*)g.A + (size_t)cur.pm * tstepA; const char* cB = (const char*)g.Bt + (size_t)cur.pnb * tstepB;
    if constexpr (KSPLIT) { cA += (size_t)cur.kc * K * 2; cB += (size_t)cur.kc * K * 2; }
    PG8_STAGE(PG8_SB(0, 0), cB, voffB); PG8_STAGE(PG8_SB(0, 1), cB + hstepB, voffB); PG8_STAGE_A(0, 0, cA, false); PG8_STAGE_A(0, 1, cA, false);
    if (wr == 1) PG8_BAR;
    PG8_WAIT_V(2); PG8_BAR;
    PG8_STAGE(PG8_SB(1, 0), cB + kstep, voffB); PG8_STAGE_A(1, 0, cA + kstep, false); PG8_STAGE(PG8_SB(1, 1), cB + hstepB + kstep, voffB);
    PG8_WAIT_V(6); PG8_BAR;
    float rsv[8];
    for (;;) {
        const bool has_next = S.next(ui + 1, nxt);
        if constexpr (Epi::SCALE) E.pre(cur, wr, fr, rsv);
        if constexpr (GATHER) {
            asm volatile("" : "+v"(tkn[0]), "+v"(tkn[1]));
        }
        const char* nA = GATHER ? cA : (has_next ? (const char*)g.A + (size_t)nxt.pm * tstepA : cA); const char* nB = has_next ? (const char*)g.Bt + (size_t)nxt.pnb * tstepB : cB;
        if constexpr (KSPLIT) { if (has_next) { nA += (size_t)nxt.kc * K * 2; nB += (size_t)nxt.kc * K * 2; } }
        for (int t = 0; t < nt; t += 2) {
            const bool last = (t == nt - 2);
            const bool un = last && has_next;
            const char* a1 = cA + (size_t)(t + 1) * kstep;
            const char* a2 = last ? nA : cA + (size_t)(t + 2) * kstep; const char* b2 = last ? nB : cB + (size_t)(t + 2) * kstep;
            const char* a3 = a2 + kstep; const char* b3 = b2 + kstep;
            PG8_LDB(B0, 0, 0); PG8_LDB(B1, 0, 1); SBAR(); PG8_LDA(At, 0, 0); PG8_STAGE_A(1, 1, a1, false);
            PG8_WAIT_V(8); PG8_WAIT_L(0); PG8_BAR; PG8_MMA(0, 0, At, B0); PG8_MMA(0, 1, At, B1); PG8_BAR; SBAR();
            PG8_LDA(At, 0, 1); PG8_STAGE(PG8_SB(0, 0), b2, voffB); PG8_STAGE(PG8_SB(0, 1), b2 + hstepB, voffB); PG8_STAGE_A(0, 0, a2, un);
            PG8_WAIT_V(8); PG8_WAIT_L(0); PG8_BAR; PG8_MMA(1, 0, At, B0); PG8_MMA(1, 1, At, B1); PG8_BAR; SBAR();
            PG8_LDB(B0, 1, 0); PG8_LDB(B1, 1, 1); SBAR(); PG8_LDA(At, 1, 0); PG8_STAGE_A(0, 1, a2, un);
            PG8_WAIT_V(8); PG8_WAIT_L(0); PG8_BAR; PG8_MMA(0, 0, At, B0); PG8_MMA(0, 1, At, B1); PG8_BAR; SBAR();
            PG8_LDA(At, 1, 1); PG8_STAGE(PG8_SB(1, 0), b3, voffB); PG8_STAGE(PG8_SB(1, 1), b3 + hstepB, voffB); PG8_STAGE_A(1, 0, a3, un);
            PG8_WAIT_V(8); PG8_WAIT_L(0); PG8_BAR; PG8_MMA(1, 0, At, B0); PG8_MMA(1, 1, At, B1); PG8_BAR; SBAR();
        }
        if constexpr (ALIGN_EPI) { if (wr == 0) PG8_BAR; }
        if constexpr (Epi::SCALE) E(acc, cur, wr, wc, fr, fq, rsv); else E(acc, cur, wr, wc, fr, fq);
        if (!has_next) break;
#pragma unroll
        for (int a = 0; a < 2; ++a)
#pragma unroll
            for (int b = 0; b < 2; ++b)
#pragma unroll
                for (int m = 0; m < 4; ++m)
#pragma unroll
                    for (int n = 0; n < 2; ++n) acc[a][b][m][n] = (f32x4){0.f, 0.f, 0.f, 0.f};
        cur = nxt; cA = nA; cB = nB; ++ui;
        if constexpr (GATHER) {
            tkc[0] = tkn[0]; tkc[1] = tkn[1];
            Unit n2; if (S.next(ui + 1, n2)) PG8_TOKS(tkn, n2);
        }
        if constexpr (ALIGN_EPI) { if (wr == 1) PG8_BAR; }
    }
    PG8_WAIT_V(0);
    if constexpr (!ALIGN_EPI) { if (wr == 0) PG8_BAR; }
    PG8_BAR;
#undef PG8_SA
#undef PG8_SB
#undef PG8_STAGE
#undef PG8_STAGE_A
#undef PG8_TOKS
#undef PG8_LDA
#undef PG8_LDB
#undef PG8_MMA
#undef PG8_WAIT_V
#undef PG8_WAIT_L
#undef PG8_BAR
}
}

namespace att {
constexpr int SHM_K = 64 * 256, SHM_V = 64 * 64 * 2;
constexpr int L_K = 0, L_V = 2 * SHM_K, L_WS = L_V + 2 * SHM_V, L_RPB = L_WS + 8 * 256, L_END = L_RPB + 2048;
#define KSWZ(row, colB) ((row) * 256 + ((colB) ^ (((row) & 15) << 4)))
__device__ __forceinline__ int crow(int r, int hi) { return (r & 3) + 8 * (r >> 2) + 4 * hi; }
__device__ __forceinline__ int v_st(int k, int c) { const int kk = (k & ~0xC) | ((k & 4) << 1) | ((k & 8) >> 1); return ((kk >> 3) * 2 + (c >> 5)) * 512 + ((kk & 7) * 32 + (c & 31)) * 2; }
__device__ __forceinline__ int v_rd_base(int lane) { return ((lane & 3) << 3) | (((lane >> 2) & 3) << 6) | (((lane >> 4) & 1) << 5) | (((lane >> 5) & 1) << 8); }
constexpr int v_rd_off(int d0, int ks, int half) { return d0 * 512 + ks * 2048 + half * 1024; }
template <int OFF> __device__ __forceinline__ s16x4 tr_read(int vb) { s16x4 r; asm volatile("ds_read_b64_tr_b16 %0, %1 offset:%2" : "=&v"(r) : "v"(vb), "i"(OFF) : "memory"); return r; }

__device__ __forceinline__ void partialSM(f32x16& p0, f32x16& p1, float& m_reg, float& mn, float& alpha, const float C, const float THRR) {
  float ma = fmaxf(fmaxf(p0[0], p0[1]), p0[2]), mb = fmaxf(fmaxf(p1[0], p1[1]), p1[2]);
#pragma unroll
  for (int r = 3; r < 15; r += 2) { ma = fmaxf(fmaxf(ma, p0[r]), p0[r + 1]); mb = fmaxf(fmaxf(mb, p1[r]), p1[r + 1]); }
  float pmax = fmaxf(fmaxf(ma, p0[15]), fmaxf(mb, p1[15]));
  if (__builtin_expect(__all(pmax - m_reg <= THRR), 1)) { mn = m_reg; alpha = 1.f; }
  else { { auto rr = __builtin_amdgcn_permlane32_swap(__float_as_uint(pmax), __float_as_uint(pmax), false, false);
           pmax = fmaxf(__uint_as_float(rr[0]), __uint_as_float(rr[1])); }
    mn = fmaxf(m_reg, pmax); alpha = __builtin_amdgcn_exp2f((m_reg - mn) * C); m_reg = mn; }
  const float mnC = -mn * C;
#pragma unroll
  for (int r = 0; r < 16; ++r) p0[r] = fmaf(p0[r], C, mnC);
#pragma unroll
  for (int r = 0; r < 16; ++r) p1[r] = fmaf(p1[r], C, mnC);
#pragma unroll
  for (int r = 0; r < 16; ++r) p0[r] = __builtin_amdgcn_exp2f(p0[r]);
}
__device__ __forceinline__ void finishSM(f32x16& p0, f32x16& p1, float alpha, float& l_reg, bf16x8& pa0, bf16x8& pa1, bf16x8& pa2, bf16x8& pa3) {
#pragma unroll
  for (int r = 0; r < 16; ++r) p1[r] = __builtin_amdgcn_exp2f(p1[r]);
  float s0 = p0[0], s1 = p0[8], s2 = p1[0], s3 = p1[8];
#pragma unroll
  for (int r = 1; r < 8; ++r) { s0 += p0[r]; s1 += p0[8 + r]; s2 += p1[r]; s3 += p1[8 + r]; }
  float ps = (s0 + s1) + (s2 + s3);
  { auto rr = __builtin_amdgcn_permlane32_swap(__float_as_uint(ps), __float_as_uint(ps), false, false);
    ps = __uint_as_float(rr[0]) + __uint_as_float(rr[1]); }
  l_reg = l_reg * alpha + ps;
#define PK4(P, BASE, OUT) do { unsigned a0 = cvt_pk_bf16(P[BASE + 0], P[BASE + 1]), a1 = cvt_pk_bf16(P[BASE + 2], P[BASE + 3]);   \
    unsigned b0 = cvt_pk_bf16(P[BASE + 4], P[BASE + 5]), b1 = cvt_pk_bf16(P[BASE + 6], P[BASE + 7]);                              \
    auto r0 = __builtin_amdgcn_permlane32_swap(a0, b0, false, false); auto r1 = __builtin_amdgcn_permlane32_swap(a1, b1, false, false); \
    u32x4 w = {r0[0], r1[0], r0[1], r1[1]}; OUT = __builtin_bit_cast(bf16x8, w); } while (0)
  PK4(p0, 0, pa0); PK4(p0, 8, pa1); PK4(p1, 0, pa2); PK4(p1, 8, pa3);
#undef PK4
}
__device__ __forceinline__ void maskedSM(f32x16& p0, f32x16& p1, unsigned vm0, unsigned vm1, float& m_reg, float& alpha, const float C, const float THRR) {
  float pmax = p0[0];
#pragma unroll
  for (int r = 1; r < 16; ++r) pmax = fmaxf(pmax, p0[r]);
#pragma unroll
  for (int r = 0; r < 16; ++r) pmax = fmaxf(pmax, p1[r]);
  { auto rr = __builtin_amdgcn_permlane32_swap(__float_as_uint(pmax), __float_as_uint(pmax), false, false);
    pmax = fmaxf(__uint_as_float(rr[0]), __uint_as_float(rr[1])); }
  float mn;
  if (__builtin_expect(__all(pmax - m_reg <= THRR), 1)) { mn = m_reg; alpha = 1.f; }
  else { mn = fmaxf(m_reg, pmax); alpha = __builtin_amdgcn_exp2f((m_reg - mn) * C); m_reg = mn; }
  const float mnC = -mn * C;
#pragma unroll
  for (int r = 0; r < 16; ++r) { const float e0 = __builtin_amdgcn_exp2f(fmaf(p0[r], C, mnC)), e1 = __builtin_amdgcn_exp2f(fmaf(p1[r], C, mnC));
    p0[r] = ((vm0 >> r) & 1u) ? e0 : 0.f; p1[r] = ((vm1 >> r) & 1u) ? e1 : 0.f; }
}
__device__ __forceinline__ void packSM(const f32x16& p0, const f32x16& p1, float alpha, float& l_reg, bf16x8& pa0, bf16x8& pa1, bf16x8& pa2, bf16x8& pa3) {
  float ps = 0;
#pragma unroll
  for (int r = 0; r < 16; ++r) ps += p0[r];
#pragma unroll
  for (int r = 0; r < 16; ++r) ps += p1[r];
  { auto rr = __builtin_amdgcn_permlane32_swap(__float_as_uint(ps), __float_as_uint(ps), false, false);
    ps = __uint_as_float(rr[0]) + __uint_as_float(rr[1]); }
  l_reg = l_reg * alpha + ps;
#define PK4(P, BASE, OUT) do { unsigned a0 = cvt_pk_bf16(P[BASE + 0], P[BASE + 1]), a1 = cvt_pk_bf16(P[BASE + 2], P[BASE + 3]);   \
    unsigned b0 = cvt_pk_bf16(P[BASE + 4], P[BASE + 5]), b1 = cvt_pk_bf16(P[BASE + 6], P[BASE + 7]);                              \
    auto r0 = __builtin_amdgcn_permlane32_swap(a0, b0, false, false); auto r1 = __builtin_amdgcn_permlane32_swap(a1, b1, false, false); \
    u32x4 w = {r0[0], r1[0], r0[1], r1[1]}; OUT = __builtin_bit_cast(bf16x8, w); } while (0)
  PK4(p0, 0, pa0); PK4(p0, 8, pa1); PK4(p1, 0, pa2); PK4(p1, 8, pa3);
#undef PK4
}
template <int NKS> __device__ __forceinline__ void qkt(f32x16& p0, f32x16& p1, const LAS char* Ks, const bf16x8* qr, int r32, int hi) {
  p0 = f32x16{}; p1 = f32x16{};
#pragma unroll
  for (int d0 = 0; d0 < NKS; ++d0) { const int cb = (d0 * 16 + hi * 8) * 2;
    const bf16x8 b0 = *(const LAS bf16x8*)(Ks + KSWZ(r32, cb));
    const bf16x8 b1 = *(const LAS bf16x8*)(Ks + KSWZ(32 + r32, cb));
    p0 = __builtin_amdgcn_mfma_f32_32x32x16_bf16(b0, qr[d0], p0, 0, 0, 0);
    p1 = __builtin_amdgcn_mfma_f32_32x32x16_bf16(b1, qr[d0], p1, 0, 0, 0); }
}
template <int D0> __device__ __forceinline__ void pv_one(f32x16& od, int vb, bf16x8 pa0, bf16x8 pa1, bf16x8 pa2, bf16x8 pa3) {
  const s16x4 l0 = tr_read<v_rd_off(D0, 0, 0)>(vb), h0 = tr_read<v_rd_off(D0, 0, 1)>(vb), l1 = tr_read<v_rd_off(D0, 1, 0)>(vb), h1 = tr_read<v_rd_off(D0, 1, 1)>(vb);
  const s16x4 l2 = tr_read<v_rd_off(D0, 2, 0)>(vb), h2 = tr_read<v_rd_off(D0, 2, 1)>(vb), l3 = tr_read<v_rd_off(D0, 3, 0)>(vb), h3 = tr_read<v_rd_off(D0, 3, 1)>(vb);
  asm volatile("s_waitcnt lgkmcnt(0)" ::: "memory"); SBAR();
#define PK(L, H) (bf16x8){L[0], L[1], L[2], L[3], H[0], H[1], H[2], H[3]}
  od = __builtin_amdgcn_mfma_f32_32x32x16_bf16(pa0, PK(l0, h0), od, 0, 0, 0);
  od = __builtin_amdgcn_mfma_f32_32x32x16_bf16(pa1, PK(l1, h1), od, 0, 0, 0);
  od = __builtin_amdgcn_mfma_f32_32x32x16_bf16(pa2, PK(l2, h2), od, 0, 0, 0);
  od = __builtin_amdgcn_mfma_f32_32x32x16_bf16(pa3, PK(l3, h3), od, 0, 0, 0);
#undef PK
}
__device__ __forceinline__ void pv2(f32x16* o, int vb, bf16x8 pa0, bf16x8 pa1, bf16x8 pa2, bf16x8 pa3) { pv_one<0>(o[0], vb, pa0, pa1, pa2, pa3); pv_one<1>(o[1], vb, pa0, pa1, pa2, pa3); }
__device__ __forceinline__ void pv2b(f32x16* o, int vb, bf16x8 pa0, bf16x8 pa1, bf16x8 pa2, bf16x8 pa3) {
  const s16x4 a0 = tr_read<v_rd_off(0, 0, 0)>(vb), b0 = tr_read<v_rd_off(0, 0, 1)>(vb), a1 = tr_read<v_rd_off(0, 1, 0)>(vb), b1 = tr_read<v_rd_off(0, 1, 1)>(vb);
  const s16x4 a2 = tr_read<v_rd_off(0, 2, 0)>(vb), b2 = tr_read<v_rd_off(0, 2, 1)>(vb), a3 = tr_read<v_rd_off(0, 3, 0)>(vb), b3 = tr_read<v_rd_off(0, 3, 1)>(vb);
  const s16x4 c0 = tr_read<v_rd_off(1, 0, 0)>(vb), d0 = tr_read<v_rd_off(1, 0, 1)>(vb), c1 = tr_read<v_rd_off(1, 1, 0)>(vb), d1 = tr_read<v_rd_off(1, 1, 1)>(vb);
  const s16x4 c2 = tr_read<v_rd_off(1, 2, 0)>(vb), d2 = tr_read<v_rd_off(1, 2, 1)>(vb), c3 = tr_read<v_rd_off(1, 3, 0)>(vb), d3 = tr_read<v_rd_off(1, 3, 1)>(vb);
  asm volatile("s_waitcnt lgkmcnt(0)" ::: "memory"); SBAR();
#define PK(L, H) (bf16x8){L[0], L[1], L[2], L[3], H[0], H[1], H[2], H[3]}
  o[0] = __builtin_amdgcn_mfma_f32_32x32x16_bf16(pa0, PK(a0, b0), o[0], 0, 0, 0); o[1] = __builtin_amdgcn_mfma_f32_32x32x16_bf16(pa0, PK(c0, d0), o[1], 0, 0, 0);
  o[0] = __builtin_amdgcn_mfma_f32_32x32x16_bf16(pa1, PK(a1, b1), o[0], 0, 0, 0); o[1] = __builtin_amdgcn_mfma_f32_32x32x16_bf16(pa1, PK(c1, d1), o[1], 0, 0, 0);
  o[0] = __builtin_amdgcn_mfma_f32_32x32x16_bf16(pa2, PK(a2, b2), o[0], 0, 0, 0); o[1] = __builtin_amdgcn_mfma_f32_32x32x16_bf16(pa2, PK(c2, d2), o[1], 0, 0, 0);
  o[0] = __builtin_amdgcn_mfma_f32_32x32x16_bf16(pa3, PK(a3, b3), o[0], 0, 0, 0); o[1] = __builtin_amdgcn_mfma_f32_32x32x16_bf16(pa3, PK(c3, d3), o[1], 0, 0, 0);
#undef PK
}
#define ATT_RESC(a) do { if (__any((a) < 1.f)) { if (hi == 0) al_l[r32] = (a); asm volatile("s_waitcnt lgkmcnt(0)" ::: "memory"); \
    _Pragma("unroll") for (int d = 0; d < 2; ++d) _Pragma("unroll") for (int r = 0; r < 16; ++r) o[d][r] *= al_l[crow(r, hi)]; } } while (0)

constexpr int M2_K = 0, M2_V = 4 * SHM_K, M2_WS = M2_V + 4 * SHM_V, M2_END = M2_WS + 8 * 256;
__device__ __forceinline__ void glds16(unsigned voff, const void* sbase, unsigned lds_dst) { unsigned keep;
  asm volatile("s_mov_b32 %0, m0\n\ts_mov_b32 m0, %3\n\ts_nop 0\n\tglobal_load_lds_dwordx4 %1, %2\n\ts_mov_b32 m0, %0" : "=&s"(keep) : "v"(voff), "s"(sbase), "s"(lds_dst) : "memory"); }
#define MLA_WAIT_BAR() asm volatile("s_waitcnt vmcnt(0) lgkmcnt(0)\n\ts_barrier" ::: "memory")
__device__ __forceinline__ void packP(const f32x16& p0, const f32x16& p1, float alpha, float& l_reg, bf16x8& pa0, bf16x8& pa1, bf16x8& pa2, bf16x8& pa3) {
  float s0 = p0[0], s1 = p0[8], s2 = p1[0], s3 = p1[8];
#pragma unroll
  for (int r = 1; r < 8; ++r) { s0 += p0[r]; s1 += p0[8 + r]; s2 += p1[r]; s3 += p1[8 + r]; }
  float ps = (s0 + s1) + (s2 + s3);
  { auto rr = __builtin_amdgcn_permlane32_swap(__float_as_uint(ps), __float_as_uint(ps), false, false);
    ps = __uint_as_float(rr[0]) + __uint_as_float(rr[1]); }
  l_reg = l_reg * alpha + ps;
#define PK4N(P, BASE, OUT) do { u32x4 w = {cvt_pk_bf16(P[BASE + 0], P[BASE + 1]), cvt_pk_bf16(P[BASE + 2], P[BASE + 3]), cvt_pk_bf16(P[BASE + 4], P[BASE + 5]), cvt_pk_bf16(P[BASE + 6], P[BASE + 7])}; OUT = __builtin_bit_cast(bf16x8, w); } while (0)
  PK4N(p0, 0, pa0); PK4N(p0, 8, pa1); PK4N(p1, 0, pa2); PK4N(p1, 8, pa3);
#undef PK4N
}
__device__ __forceinline__ void finishSM2(f32x16& p0, f32x16& p1, float alpha, float& l_reg, bf16x8& pa0, bf16x8& pa1, bf16x8& pa2, bf16x8& pa3) {
#pragma unroll
  for (int r = 0; r < 16; ++r) p1[r] = __builtin_amdgcn_exp2f(p1[r]);
  packP(p0, p1, alpha, l_reg, pa0, pa1, pa2, pa3);
}
__device__ __forceinline__ void partialSM2(f32x16& p0, f32x16& p1, float& m_reg, f32x16& negm, float& alpha, const float THRL) {
  float ma = fmaxf(fmaxf(p0[0], p0[1]), p0[2]), mb = fmaxf(fmaxf(p1[0], p1[1]), p1[2]);
#pragma unroll
  for (int r = 3; r < 15; r += 2) { ma = fmaxf(fmaxf(ma, p0[r]), p0[r + 1]); mb = fmaxf(fmaxf(mb, p1[r]), p1[r + 1]); }
  float pmax = fmaxf(fmaxf(ma, p0[15]), fmaxf(mb, p1[15]));
  if (__builtin_expect(__all(pmax <= THRL), 1)) { alpha = 1.f; }
  else { { auto rr = __builtin_amdgcn_permlane32_swap(__float_as_uint(pmax), __float_as_uint(pmax), false, false);
           pmax = fmaxf(__uint_as_float(rr[0]), __uint_as_float(rr[1])); }
    const float dl = fmaxf(pmax, 0.f); m_reg += dl; alpha = __builtin_amdgcn_exp2f(-dl);
#pragma unroll
    for (int r = 0; r < 16; ++r) { p0[r] -= dl; p1[r] -= dl; }
#pragma unroll
    for (int r = 0; r < 16; ++r) negm[r] = -m_reg;
    asm volatile("" : "+v"(negm)); }
#pragma unroll
  for (int r = 0; r < 16; ++r) p0[r] = __builtin_amdgcn_exp2f(p0[r]);
}
template <int NKS> __device__ __forceinline__ void qkt_m(f32x16& p0, f32x16& p1, const LAS char* Ks, const bf16x8* qr, const f32x16& negm, int r32, int hi) {
  bf16x8 kf[2 * NKS];
#pragma unroll
  for (int d0 = 0; d0 < NKS; ++d0) { const int cb = (d0 * 16 + hi * 8) * 2;
    kf[2 * d0] = *(const LAS bf16x8*)(Ks + KSWZ(r32, cb)); kf[2 * d0 + 1] = *(const LAS bf16x8*)(Ks + KSWZ(32 + r32, cb)); }
  SBAR();
#pragma unroll
  for (int d0 = 0; d0 < NKS; ++d0) {
    if (d0 == 0) { p0 = __builtin_amdgcn_mfma_f32_32x32x16_bf16(kf[0], qr[0], negm, 0, 0, 0); p1 = __builtin_amdgcn_mfma_f32_32x32x16_bf16(kf[1], qr[0], negm, 0, 0, 0); }
    else { p0 = __builtin_amdgcn_mfma_f32_32x32x16_bf16(kf[2 * d0], qr[d0], p0, 0, 0, 0); p1 = __builtin_amdgcn_mfma_f32_32x32x16_bf16(kf[2 * d0 + 1], qr[d0], p1, 0, 0, 0); } }
}
template <int OFF> __device__ __forceinline__ bf16x8 lds_rd128(int a) { bf16x8 r; asm volatile("ds_read_b128 %0, %1 offset:%2" : "=&v"(r) : "v"(a), "i"(OFF) : "memory"); return r; }
__device__ __forceinline__ void mla_mseg(f32x16& p0, f32x16& p1, f32x16* o, int kb, int vb, const bf16x8* qr, const f32x16& negm, bf16x8 pa0, bf16x8 pa1, bf16x8 pa2, bf16x8 pa3, int r32, int hi) {
  bf16x8 kf[12];
#pragma unroll
  for (int d = 0; d < 6; ++d) { const int a = kb + KSWZ(r32, (d * 16 + hi * 8) * 2); kf[2 * d] = lds_rd128<0>(a); kf[2 * d + 1] = lds_rd128<8192>(a); }
#define KW(N, A, B) asm volatile("s_waitcnt lgkmcnt(" #N ")" : "+v"(A), "+v"(B) :: "memory")
  KW(10, kf[0], kf[1]); p0 = __builtin_amdgcn_mfma_f32_32x32x16_bf16(kf[0], qr[0], negm, 0, 0, 0); p1 = __builtin_amdgcn_mfma_f32_32x32x16_bf16(kf[1], qr[0], negm, 0, 0, 0);
  SBAR(); KW(8, kf[2], kf[3]); p0 = __builtin_amdgcn_mfma_f32_32x32x16_bf16(kf[2], qr[1], p0, 0, 0, 0); p1 = __builtin_amdgcn_mfma_f32_32x32x16_bf16(kf[3], qr[1], p1, 0, 0, 0);
  SBAR(); KW(6, kf[4], kf[5]); p0 = __builtin_amdgcn_mfma_f32_32x32x16_bf16(kf[4], qr[2], p0, 0, 0, 0); p1 = __builtin_amdgcn_mfma_f32_32x32x16_bf16(kf[5], qr[2], p1, 0, 0, 0);
  SBAR(); KW(4, kf[6], kf[7]); p0 = __builtin_amdgcn_mfma_f32_32x32x16_bf16(kf[6], qr[3], p0, 0, 0, 0); p1 = __builtin_amdgcn_mfma_f32_32x32x16_bf16(kf[7], qr[3], p1, 0, 0, 0);
#undef KW
  SBAR();
  const s16x4 a0 = tr_read<v_rd_off(0, 0, 0)>(vb), b0 = tr_read<v_rd_off(0, 0, 1)>(vb), c0 = tr_read<v_rd_off(1, 0, 0)>(vb), d0 = tr_read<v_rd_off(1, 0, 1)>(vb);
  const s16x4 a1 = tr_read<v_rd_off(0, 1, 0)>(vb), b1 = tr_read<v_rd_off(0, 1, 1)>(vb), c1 = tr_read<v_rd_off(1, 1, 0)>(vb), d1 = tr_read<v_rd_off(1, 1, 1)>(vb);
  const s16x4 a2 = tr_read<v_rd_off(0, 2, 0)>(vb), b2 = tr_read<v_rd_off(0, 2, 1)>(vb), c2 = tr_read<v_rd_off(1, 2, 0)>(vb), d2 = tr_read<v_rd_off(1, 2, 1)>(vb);
  const s16x4 a3 = tr_read<v_rd_off(0, 3, 0)>(vb), b3 = tr_read<v_rd_off(0, 3, 1)>(vb), c3 = tr_read<v_rd_off(1, 3, 0)>(vb), d3 = tr_read<v_rd_off(1, 3, 1)>(vb);
  asm volatile("s_waitcnt lgkmcnt(15)" : "+v"(kf[8]), "+v"(kf[9]), "+v"(kf[10]), "+v"(kf[11]) :: "memory");
  p0 = __builtin_amdgcn_mfma_f32_32x32x16_bf16(kf[8], qr[4], p0, 0, 0, 0); p1 = __builtin_amdgcn_mfma_f32_32x32x16_bf16(kf[9], qr[4], p1, 0, 0, 0);
  p0 = __builtin_amdgcn_mfma_f32_32x32x16_bf16(kf[10], qr[5], p0, 0, 0, 0); p1 = __builtin_amdgcn_mfma_f32_32x32x16_bf16(kf[11], qr[5], p1, 0, 0, 0);
  SBAR(); asm volatile("s_waitcnt lgkmcnt(0)" ::: "memory"); SBAR();
#define PK(L, H) (bf16x8){L[0], L[1], L[2], L[3], H[0], H[1], H[2], H[3]}
  o[0] = __builtin_amdgcn_mfma_f32_32x32x16_bf16(pa0, PK(a0, b0), o[0], 0, 0, 0); o[1] = __builtin_amdgcn_mfma_f32_32x32x16_bf16(pa0, PK(c0, d0), o[1], 0, 0, 0);
  o[0] = __builtin_amdgcn_mfma_f32_32x32x16_bf16(pa1, PK(a1, b1), o[0], 0, 0, 0); o[1] = __builtin_amdgcn_mfma_f32_32x32x16_bf16(pa1, PK(c1, d1), o[1], 0, 0, 0);
  o[0] = __builtin_amdgcn_mfma_f32_32x32x16_bf16(pa2, PK(a2, b2), o[0], 0, 0, 0); o[1] = __builtin_amdgcn_mfma_f32_32x32x16_bf16(pa2, PK(c2, d2), o[1], 0, 0, 0);
  o[0] = __builtin_amdgcn_mfma_f32_32x32x16_bf16(pa3, PK(a3, b3), o[0], 0, 0, 0); o[1] = __builtin_amdgcn_mfma_f32_32x32x16_bf16(pa3, PK(c3, d3), o[1], 0, 0, 0);
#undef PK
}
__device__ __forceinline__ void mla_unit(int b, int h, int qb, int kh, const bf16_t* __restrict__ QB, const bf16_t* __restrict__ KVB, const bf16_t* __restrict__ KR, bf16_t* __restrict__ OA, f32x2* __restrict__ ML, LAS char* lds) {
  int tid = threadIdx.x; asm volatile("" : "+v"(tid));
  const int wid = __builtin_amdgcn_readfirstlane(tid >> 6), lane = tid & 63, r32 = lane & 31, hi = lane >> 5;
  LAS char* K_lds = lds + M2_K;
  LAS float* wsf = (LAS float*)(lds + M2_WS) + wid * 64; LAS float* li_l = wsf; LAS float* al_l = wsf + 32;
  constexpr float SCALE = 0.10206207261596575f, C = SCALE * 1.4426950408889634f, THRL = 8.0f * 1.4426950408889634f;
  const long rowbase = (long)b * SEQ; const int qpos = qb * 256 + wid * 32 + r32;
  const long keybase = rowbase + (long)kh * (SEQ / 2);
  const char* const sbase = (const char*)KVB < (const char*)KR ? (const char*)KVB : (const char*)KR;
  const unsigned okv = (unsigned)((const char*)KVB - sbase), okr = (unsigned)((const char*)KR - sbase);
  unsigned ksrc[2], kstr[2];
#pragma unroll
  for (int i = 0; i < 2; ++i) { const int p = wid * 2 + i, row = 4 * p + (lane >> 4), c = (lane & 15) ^ (row & 15);
    if (c < 8) { ksrc[i] = okv + (unsigned)(((keybase + row) * 768 + h * 128 + c * 8) * 2); kstr[i] = 64u * 768u * 2u; }
    else { const int rc = c - 8; ksrc[i] = okr + (unsigned)(((keybase + row) * 32 + ((rc < 4 ? rc : 0) * 8)) * 2); kstr[i] = 64u * 32u * 2u; } }
  unsigned vsrc = okv + (unsigned)(((keybase + 8 * wid + ((lane & 31) >> 2)) * 768 + h * 128 + 64 + (lane >> 5) * 32 + (lane & 3) * 8) * 2);
  const unsigned lds0 = (unsigned)(size_t)lds;
  const unsigned kdst = lds0 + M2_K + wid * 2048, vdst = lds0 + M2_V + wid * 1024;
#define MLA_DMA(slot) do { glds16(ksrc[0], sbase, (unsigned)__builtin_amdgcn_readfirstlane(kdst + (slot) * SHM_K)); glds16(ksrc[1], sbase, (unsigned)__builtin_amdgcn_readfirstlane(kdst + (slot) * SHM_K + 1024)); \
    glds16(vsrc, sbase, (unsigned)__builtin_amdgcn_readfirstlane(vdst + (slot) * SHM_V)); ksrc[0] += kstr[0]; ksrc[1] += kstr[1]; vsrc += 64u * 768u * 2u; } while (0)
  MLA_DMA(0);
  float m_reg = 0.f, l_reg = 0.f; f32x16 o[2] = {}; bf16x8 qr[6];
  { const bf16_t* Qw = QB + (rowbase + qpos) * 768 + h * 96 + hi * 8;
#pragma unroll
    for (int d0 = 0; d0 < 6; ++d0) qr[d0] = *(const bf16x8*)(Qw + d0 * 16);
#pragma unroll
    for (int d0 = 0; d0 < 4; ++d0) { u32x4 x = __builtin_bit_cast(u32x4, qr[d0]);
#pragma unroll
      for (int i = 0; i < 4; ++i) x[i] = cvt_pk_bf16(bflo(x[i]) * C, bfhi(x[i]) * C);
      qr[d0] = __builtin_bit_cast(bf16x8, x); }
    u32x4 x1 = __builtin_bit_cast(u32x4, qr[4]), x2 = __builtin_bit_cast(u32x4, qr[5]); u32x4 y1, y2;
#pragma unroll
    for (int i = 0; i < 4; ++i) { float c0, s0, c1, s1; rope_cs(qpos, hi * 8 + 2 * i, c0, s0); rope_cs(qpos, hi * 8 + 2 * i + 1, c1, s1);
      const float a0 = bflo(x1[i]) * C, a1 = bfhi(x1[i]) * C, b0 = bflo(x2[i]) * C, b1 = bfhi(x2[i]) * C;
      y1[i] = cvt_pk_bf16(a0 * c0 - b0 * s0, a1 * c1 - b1 * s1); y2[i] = cvt_pk_bf16(a0 * s0 + b0 * c0, a1 * s1 + b1 * c1); }
    qr[4] = __builtin_bit_cast(bf16x8, y1); qr[5] = __builtin_bit_cast(bf16x8, y2); }
  const int vb0 = (int)lds0 + M2_V + v_rd_base(lane);
  f32x16 p0, p1; float al = 1.f; bf16x8 pa0, pa1, pa2, pa3; constexpr int NT = SEQ / 128;
  f32x16 negm = f32x16{}; asm volatile("" : "+v"(negm)); m_reg = 0.f;
  const int grp = wid >> 2;
#define MLA_BAR_L() asm volatile("s_waitcnt lgkmcnt(0)\n\ts_barrier" ::: "memory")
#define MLA_BAR_V3() asm volatile("s_waitcnt vmcnt(3) lgkmcnt(0)\n\ts_barrier" ::: "memory")
#define MLA_SOFTMAX() do { SBAR(); partialSM2(p0, p1, m_reg, negm, al, THRL); finishSM2(p0, p1, al, l_reg, pa0, pa1, pa2, pa3); ATT_RESC(al); SBAR(); } while (0)
#define MLA_MSEG(sk_, sv_) do { SBAR(); __builtin_amdgcn_s_setprio(2); mla_mseg(p0, p1, o, (int)lds0 + M2_K + (sk_) * SHM_K, vb0 + (sv_) * SHM_V, qr, negm, pa0, pa1, pa2, pa3, r32, hi); __builtin_amdgcn_s_setprio(0); SBAR(); } while (0)
  MLA_DMA(1);
  MLA_WAIT_BAR();
  if (grp == 0) {
    SBAR(); qkt_m<6>(p0, p1, K_lds, qr, negm, r32, hi); SBAR();
    MLA_BAR_L();
    if (2 < NT) MLA_DMA(2);
    MLA_SOFTMAX();
    MLA_BAR_V3();
#pragma unroll 1
    for (int j = 1; j < NT; ++j) {
      MLA_MSEG(j & 3, (j - 1) & 3);
      MLA_BAR_L();
      if (j + 2 < NT) MLA_DMA((j + 2) & 3);
      MLA_SOFTMAX();
      if (j + 2 < NT) MLA_BAR_V3(); else MLA_WAIT_BAR();
    }
    SBAR(); pv2b(o, vb0 + ((NT - 1) & 3) * SHM_V, pa0, pa1, pa2, pa3); SBAR();
    MLA_BAR_L();
    MLA_WAIT_BAR();
  } else {
    if (2 < NT) MLA_DMA(2);
    MLA_BAR_L();
    SBAR(); qkt_m<6>(p0, p1, K_lds, qr, negm, r32, hi); SBAR();
    MLA_BAR_V3();
#pragma unroll 1
    for (int j = 1; j < NT; ++j) {
      if (j + 2 < NT) MLA_DMA((j + 2) & 3);
      MLA_SOFTMAX();
      MLA_BAR_L();
      MLA_MSEG(j & 3, (j - 1) & 3);
      if (j + 2 < NT) MLA_BAR_V3(); else MLA_WAIT_BAR();
    }
    MLA_SOFTMAX();
    MLA_BAR_L();
    SBAR(); pv2b(o, vb0 + ((NT - 1) & 3) * SHM_V, pa0, pa1, pa2, pa3); SBAR();
    MLA_WAIT_BAR();
  }
#undef MLA_BAR_L
#undef MLA_BAR_V3
#undef MLA_SOFTMAX
#undef MLA_MSEG
#undef MLA_DMA
  if (hi == 0) li_l[r32] = l_reg;
  asm volatile("s_waitcnt lgkmcnt(0)" ::: "memory");
  if (hi == 0) ML[((size_t)(3 + kh) * MTOK + rowbase + qpos) * 8 + h] = (f32x2){0.6931471805599453f * m_reg, l_reg};
  bf16_t* Ow = OA + ((size_t)(3 + kh) * MTOK + rowbase + qb * 256 + wid * 32) * 384 + h * 64 + r32;
#pragma unroll
  for (int r = 0; r < 16; ++r) { const int orow = crow(r, hi); const float rl = __builtin_amdgcn_rcpf(li_l[orow]);
#pragma unroll
    for (int d0 = 0; d0 < 2; ++d0) Ow[(long)orow * 384 + d0 * 32] = (bf16_t)(cvt_pk_bf16(o[d0][r] * rl, 0.f) & 0xffffu); }
  asm volatile("s_waitcnt lgkmcnt(0)\n\ts_barrier" ::: "memory");
}

constexpr int WT_BYTES = 16384;
constexpr int W_RPB = 6 * WT_BYTES, W_WS = W_RPB + 2560, W_END = W_WS + 8 * 256;
#define KSWZ128(row, colB) ((row) * 128 + ((colB) ^ ((((row) >> 1) & 7) << 4)))
__device__ __forceinline__ void qkt128(f32x16& p0, f32x16& p1, const LAS char* Ks, const bf16x8* qr, int r32, int hi) {
  p0 = f32x16{}; p1 = f32x16{};
#pragma unroll
  for (int d0 = 0; d0 < 4; ++d0) { const int cb = (d0 * 16 + hi * 8) * 2;
    const bf16x8 b0 = *(const LAS bf16x8*)(Ks + KSWZ128(r32, cb));
    const bf16x8 b1 = *(const LAS bf16x8*)(Ks + KSWZ128(32 + r32, cb));
    p0 = __builtin_amdgcn_mfma_f32_32x32x16_bf16(b0, qr[d0], p0, 0, 0, 0);
    p1 = __builtin_amdgcn_mfma_f32_32x32x16_bf16(b1, qr[d0], p1, 0, 0, 0); }
}
#define WIN_SOFTMAX_PV(slot) do { float al_, mn_; bf16x8 pa0, pa1, pa2, pa3; partialSM(p0, p1, m_reg, mn_, al_, C, THRR); finishSM(p0, p1, al_, l_reg, pa0, pa1, pa2, pa3); \
    ATT_RESC(al_); pv2(o, vb0 + (slot) * WT_BYTES, pa0, pa1, pa2, pa3); } while (0)

__device__ __forceinline__ void dil_phase(int ua0, int na, const bf16_t* __restrict__ PROJ, bf16_t* __restrict__ OA, f32x2* __restrict__ ML, LAS char* lds) {
  int tid = threadIdx.x; asm volatile("" : "+v"(tid));
  const int wid = __builtin_amdgcn_readfirstlane(tid >> 6), lane = tid & 63, r32 = lane & 31, hi = lane >> 5;
  LAS float* wsf = (LAS float*)(lds + W_WS) + wid * 64; LAS float* li_l = wsf; LAS float* al_l = wsf + 32;
  constexpr float SCALE = 0.125f, C = SCALE * 1.4426950408889634f, THRR = 8.0f / SCALE;
  const int srow = tid >> 3, sc8 = tid & 7;
  const int kst = KSWZ128(srow, sc8 * 16), vst = 8192 + v_st(srow, sc8 * 8);
  const int vb0 = (int)(unsigned)(size_t)lds + 8192 + v_rd_base(lane);
  bf16x8 sk[6], sv[6], qn[4];
#define DIL_GEO(ua) const int bh_ = (ua) / 96, rem_ = (ua) % 96, g = rem_ >> 5, uu_ = rem_ & 31, h = bh_ % 6; const long rowbase = (long)(bh_ / 6) * SEQ; \
    const int d = (g == 0) ? 1 : ((g == 1) ? 4 : 16), n = SEQ / d, res = uu_ % d, i0 = (uu_ / d) * 256
#define DIL_LOAD(ua) do { DIL_GEO(ua); _Pragma("unroll") for (int t = 0; t < 6; ++t) { int ki = i0 - 64 + 64 * t + srow; ki = min(max(ki, 0), n - 1); \
      const bf16_t* p_ = PROJ + (rowbase + (long)ki * d + res) * PJ + h * 64 + sc8 * 8; sk[t] = *(const bf16x8*)(p_ + PC_KA); sv[t] = *(const bf16x8*)(p_ + PC_VA); } \
    const bf16_t* Qw = PROJ + (rowbase + (long)(i0 + wid * 32 + r32) * d + res) * PJ + PC_QA + h * 64 + hi * 8; \
    _Pragma("unroll") for (int d0 = 0; d0 < 4; ++d0) qn[d0] = *(const bf16x8*)(Qw + d0 * 16); } while (0)
  if (na > 0) DIL_LOAD(ua0);
#pragma unroll 1
  for (int k = 0; k < na; ++k) {
    DIL_GEO(ua0 + k);
#pragma unroll
    for (int t = 0; t < 6; ++t) { *(LAS bf16x8*)(lds + t * WT_BYTES + kst) = sk[t]; *(LAS bf16x8*)(lds + t * WT_BYTES + vst) = sv[t]; }
    bf16x8 qr[4];
#pragma unroll
    for (int d0 = 0; d0 < 4; ++d0) qr[d0] = qn[d0];
    __syncthreads();
    if (k + 1 < na) DIL_LOAD(ua0 + k + 1);
    const int qi = i0 + wid * 32 + r32;
    const float slope = 8.0f * exp2f(-8.0f * (float)(h + 1) / 6.0f) * (float)d;
    float m_reg = -1e30f, l_reg = 0.f; f32x16 o[2] = {};
#pragma unroll 1
    for (int tt = 0; tt < 3; ++tt) {
      const int t = (wid >> 1) + tt;
      const int tstart = i0 - 64 + 64 * t;
      if (tstart < 0 || tstart >= n) continue;
      f32x16 p0, p1;
      qkt128(p0, p1, lds + t * WT_BYTES, qr, r32, hi);
      const float kbf = (float)(tstart - qi + 4 * hi);
#pragma unroll
      for (int r = 0; r < 16; ++r) { const float dl0 = kbf + (float)((r & 3) + 8 * (r >> 2)), dl1 = dl0 + 32.0f;
        p0[r] = (fabsf(dl0) <= 64.0f) ? fmaf(-slope, fabsf(dl0), p0[r]) : -1e30f; p1[r] = (fabsf(dl1) <= 64.0f) ? fmaf(-slope, fabsf(dl1), p1[r]) : -1e30f; }
      WIN_SOFTMAX_PV(t);
    }
    if (hi == 0) li_l[r32] = l_reg;
    asm volatile("s_waitcnt lgkmcnt(0)" ::: "memory");
    if (hi == 0) ML[((size_t)g * MTOK + rowbase + (long)qi * d + res) * 8 + h] = (f32x2){SCALE * m_reg, l_reg};
#pragma unroll
    for (int r = 0; r < 16; ++r) { const int orow = crow(r, hi); const float rl = __builtin_amdgcn_rcpf(li_l[orow]);
      bf16_t* Ow = OA + ((size_t)g * MTOK + rowbase + (long)(i0 + wid * 32 + orow) * d + res) * 384 + h * 64 + r32;
#pragma unroll
      for (int d0 = 0; d0 < 2; ++d0) Ow[d0 * 32] = (bf16_t)(cvt_pk_bf16(o[d0][r] * rl, 0.f) & 0xffffu); }
    __syncthreads();
  }
#undef DIL_GEO
#undef DIL_LOAD
}

__device__ __forceinline__ void nat_phase(int uc0, int nc, const bf16_t* __restrict__ PROJ, bf16_t* __restrict__ YC, const float* __restrict__ rpb_l, LAS char* lds) {
  int tid = threadIdx.x; asm volatile("" : "+v"(tid));
  const int wid = __builtin_amdgcn_readfirstlane(tid >> 6), lane = tid & 63, r32 = lane & 31, hi = lane >> 5;
  LAS float* wsf = (LAS float*)(lds + W_WS) + wid * 64; LAS float* li_l = wsf; LAS float* al_l = wsf + 32; LAS float* rpbL = (LAS float*)(lds + W_RPB + 256);
  constexpr float SCALE = 0.125f, C = SCALE * 1.4426950408889634f, THRR = 8.0f / SCALE;
  const int srow = tid >> 3, sc8 = tid & 7;
  const int kst = KSWZ128(srow, sc8 * 16), vst = 8192 + v_st(srow, sc8 * 8);
  const int vb0 = (int)(unsigned)(size_t)lds + 8192 + v_rd_base(lane);
  bf16x8 sk[6], sv[6], qn[4];
#define NAT_GEO(uc) const int bh_ = (uc) >> 5, uu = (uc) & 31, h = bh_ & 3; const long rowbase = (long)(bh_ >> 2) * SEQ; const bool edge = (uu == 0 || uu == 31); const int R0 = min(max(4 * uu - 4, 0), 120)
#define NAT_RL(s, t) (edge ? ((s) * 6 + (t)) : ((s) == 0 ? ((t) < 3 ? (t) : (t) + 5) : (t) + 3))
#define NAT_NT(s) (edge ? ((s) == 0 ? 6 : 2) : ((s) == 0 ? 6 : 5))
#define NAT_LOAD(uc, s) do { NAT_GEO(uc); _Pragma("unroll") for (int t = 0; t < 6; ++t) { const int rl_ = min(NAT_RL(s, t), edge ? 7 : 10); \
      const bf16_t* p_ = PROJ + (rowbase + (long)(R0 + rl_) * 64 + srow) * PJ + h * 64 + sc8 * 8; sk[t] = *(const bf16x8*)(p_ + PC_KC); sv[t] = *(const bf16x8*)(p_ + PC_VC); } \
    if ((s) == 0) { const bf16_t* Qw = PROJ + (rowbase + 256 * uu + 32 * wid + r32) * PJ + PC_QC + h * 64 + hi * 8; \
      _Pragma("unroll") for (int d0 = 0; d0 < 4; ++d0) qn[d0] = *(const bf16x8*)(Qw + d0 * 16); } } while (0)
  if (nc > 0) NAT_LOAD(uc0, 0);
  float m_reg = -1e30f, l_reg = 0.f; f32x16 o[2] = {}; bf16x8 qr[4] = {};
#pragma unroll 1
  for (int st = 0; st < 2 * nc; ++st) {
    const int s = st & 1; NAT_GEO(uc0 + (st >> 1));
#pragma unroll
    for (int t = 0; t < 6; ++t) { *(LAS bf16x8*)(lds + t * WT_BYTES + kst) = sk[t]; *(LAS bf16x8*)(lds + t * WT_BYTES + vst) = sv[t]; }
    if (s == 0) {
#pragma unroll
      for (int d0 = 0; d0 < 4; ++d0) qr[d0] = qn[d0];
      for (int t = tid; t < 15 * 31; t += 512) rpbL[t] = rpb_l[h * 465 + t] * 8.0f;
      m_reg = -1e30f; l_reg = 0.f; o[0] = f32x16{}; o[1] = f32x16{};
    }
    __syncthreads();
    if (st + 1 < 2 * nc) { if (s == 0) NAT_LOAD(uc0 + (st >> 1), 1); else NAT_LOAD(uc0 + (st >> 1) + 1, 0); }
    const int rq = 4 * uu + (wid >> 1), cq = 32 * (wid & 1) + r32, rs = min(max(rq - 4, 0), 120), cs = min(max(cq - 8, 0), 48);
    const int ntl = NAT_NT(s);
#pragma unroll 1
    for (int t = 0; t < ntl; ++t) {
      const int kr = R0 + NAT_RL(s, t);
      if (kr >= rs && kr < rs + 8) {
        f32x16 p0, p1;
        qkt128(p0, p1, lds + t * WT_BYTES, qr, r32, hi);
        const LAS float* bp = rpbL + ((kr - rq + 7) * 31 + 15 - cq + 4 * hi);
        const unsigned t0 = (unsigned)(4 * hi - cs);
#pragma unroll
        for (int r = 0; r < 16; ++r) { const int c0 = (r & 3) + 8 * (r >> 2);
          p0[r] = (t0 + (unsigned)c0 < 16u) ? p0[r] + bp[c0] : -1e30f; p1[r] = (t0 + (unsigned)(c0 + 32) < 16u) ? p1[r] + bp[c0 + 32] : -1e30f; }
        WIN_SOFTMAX_PV(t);
      }
    }
    if (s == 1) {
      if (hi == 0) li_l[r32] = l_reg;
      asm volatile("s_waitcnt lgkmcnt(0)" ::: "memory");
#pragma unroll
      for (int r = 0; r < 16; ++r) { const int orow = crow(r, hi); const float rl = __builtin_amdgcn_rcpf(li_l[orow]);
        bf16_t* Ow = YC + (rowbase + 256 * uu + 32 * wid + orow) * 256 + h * 64 + r32;
#pragma unroll
        for (int d0 = 0; d0 < 2; ++d0) Ow[d0 * 32] = (bf16_t)(cvt_pk_bf16(o[d0][r] * rl, 0.f) & 0xffffu); }
    }
    __syncthreads();
  }
#undef NAT_GEO
#undef NAT_RL
#undef NAT_NT
#undef NAT_LOAD
}
#undef WIN_SOFTMAX_PV
#undef ATT_RESC
}

#define RLX_AGENT __ATOMIC_RELAXED, __HIP_MEMORY_SCOPE_AGENT
#define XB_TMO      128
#define XB_XCNT(j)  (256  + 64 * (j))
#define XB_XSUB(j)  (1280 + 64 * (j))
#define XB_XGEN(j)  (2304 + 64 * (j))
#define XB_TOP      3328
#define XB_TOPGEN   3392
#define XCD_BAR_WORDS 3456
#define XB_SPIN_CAP (1u << 18)
__device__ __forceinline__ unsigned xb_ld(unsigned* p)              { return __hip_atomic_load(p, __ATOMIC_RELAXED, __HIP_MEMORY_SCOPE_AGENT); }
__device__ __forceinline__ unsigned xb_add(unsigned* p, unsigned v) { return __hip_atomic_fetch_add(p, v, __ATOMIC_RELAXED, __HIP_MEMORY_SCOPE_AGENT); }
__device__ __forceinline__ unsigned xb_xcc_id() { return (unsigned)__builtin_amdgcn_s_getreg((3 << 11) | 20) & 0xFu; }
#define XB_SPIN(cond, bar) do { unsigned _sp = 0; while (cond) { __builtin_amdgcn_s_sleep(1); \
    if ((++_sp & 255u) == 0u) { if (xb_ld(&(bar)[XB_TMO])) break; if (_sp > XB_SPIN_CAP) { atomicAdd(&(bar)[XB_TMO], 1u); break; } } } } while (0)
struct XcdBarrier { unsigned* bar; unsigned x; volatile LAS unsigned* st; };
__device__ __forceinline__ XcdBarrier xcd_barrier_post(unsigned* bar, volatile LAS unsigned* st) {
    XcdBarrier b; b.bar = bar; b.x = xb_xcc_id(); b.st = st;
    if (threadIdx.x == 0) (void)xb_add(&bar[XB_XCNT(b.x)], 1u);
    return b;
}
__device__ __forceinline__ void xcd_barrier_complete(unsigned* bar, unsigned x, unsigned& nloc, unsigned& nx) {
    const unsigned G = gridDim.x * gridDim.y * gridDim.z;
    unsigned sum, cnt, mine, sp = 0u;
    for (;;) {
        sum = 0u; cnt = 0u; mine = 0u;
#pragma unroll
        for (unsigned j = 0; j < 16; ++j) { const unsigned c = xb_ld(&bar[XB_XCNT(j)]); sum += c; cnt += (c > 0u) ? 1u : 0u; mine = (j == x) ? c : mine; }
        if (sum == G) break;
        __builtin_amdgcn_s_sleep(1);
        if ((++sp & 255u) == 0u) { if (xb_ld(&bar[XB_TMO])) break; if (sp > XB_SPIN_CAP) { atomicAdd(&bar[XB_TMO], 1u); break; } }
    }
    nloc = mine > 0u ? mine : 1u; nx = cnt > 0u ? cnt : 1u;
}
__device__ __forceinline__ void xcd_barrier(const XcdBarrier& b) {
    asm volatile("s_waitcnt vmcnt(0)" ::: "memory");
    __syncthreads();
    if (threadIdx.x == 0) {
        unsigned* bar = b.bar;
        __builtin_amdgcn_s_waitcnt(0);
        unsigned nloc = b.st[0], nx = b.st[1];
        if (nloc == 0u) { xcd_barrier_complete(bar, b.x, nloc, nx); b.st[0] = nloc; b.st[1] = nx; }
        const unsigned old = xb_add(&bar[XB_XSUB(b.x)], 1u);
        const unsigned gen = old / nloc;
        if (old + 1u == (gen + 1u) * nloc) {
            __builtin_amdgcn_fence(__ATOMIC_RELEASE, "agent");
            asm volatile("s_waitcnt vmcnt(0)" ::: "memory");
            const unsigned og = xb_add(&bar[XB_TOP], 1u);
            const unsigned tg = og / nx;
            if (og + 1u == (tg + 1u) * nx) xb_add(&bar[XB_TOPGEN], 1u);
            else XB_SPIN(xb_ld(&bar[XB_TOPGEN]) == tg, bar);
            __builtin_amdgcn_fence(__ATOMIC_ACQUIRE, "agent");
            xb_add(&bar[XB_XGEN(b.x)], 1u);
            asm volatile("s_waitcnt vmcnt(0)" ::: "memory");
        } else {
            XB_SPIN(xb_ld(&bar[XB_XGEN(b.x)]) == gen, bar);
            __builtin_amdgcn_fence(__ATOMIC_ACQUIRE, "agent");
            asm volatile("s_waitcnt vmcnt(0)" ::: "memory");
        }
    }
    __syncthreads();
}

constexpr int RING_OFF = 0, RING_BYTES = 131072;
constexpr int MISC_OFF = RING_BYTES;
constexpr int LDS_BYTES = 147456;
static_assert(att::L_END <= RING_BYTES && att::W_END <= RING_BYTES && att::M2_END <= RING_BYTES, "attention scratch inside the ring region");

template <class RowMap>
__device__ __forceinline__ void tr_item(const float* __restrict__ W, int K, int N, bf16_t* __restrict__ WT, LAS float* scr, int item, int lane, RowMap rm) {
    const int nblk = N / 32, kb = item / nblk, nb = item % nblk, k0 = 64 * kb, n0 = 32 * nb;
#pragma unroll 8
    for (int i = 0; i < 32; ++i) { const int kk = 2 * i + (lane >> 5); scr[kk * 33 + (lane & 31)] = W[(size_t)(k0 + kk) * N + n0 + (lane & 31)]; }
    LDS_WAIT(); asm volatile("" ::: "memory");
    const int c = lane & 7;
#pragma unroll
    for (int j = 0; j < 4; ++j) { const int n = (lane >> 3) + 8 * j; const LAS float* s = scr + (8 * c) * 33 + n;
        u32x4 o; o.x = cvt_pk_bf16(s[0 * 33], s[1 * 33]); o.y = cvt_pk_bf16(s[2 * 33], s[3 * 33]); o.z = cvt_pk_bf16(s[4 * 33], s[5 * 33]); o.w = cvt_pk_bf16(s[6 * 33], s[7 * 33]);
        *(u32x4*)(WT + (size_t)rm(n0 + n) * K + k0 + 8 * c) = o; }
    LDS_WAIT(); asm volatile("" ::: "memory");
}
struct RmId  { __device__ __forceinline__ int operator()(int n) const { return n; } };
struct RmIn  { __device__ __forceinline__ int operator()(int n) const { return n < 1792 ? n : (n < 1824 ? n + 768 : n - 32); } };
struct RmW1  { __device__ __forceinline__ int operator()(int n) const { return 8 * (n >> 2) + (n & 3); } };
struct RmW3  { __device__ __forceinline__ int operator()(int n) const { return 8 * (n >> 2) + 4 + (n & 3); } };

typedef __attribute__((address_space(4))) const unsigned char* kptr_t;
constexpr int CV_ATT = 16 * 81 + 6 * 18 + 4 * 24 + 16 * 32, CV_FFN = 3 * 16 * 88, CV_MOE = 3 * 8 * 16 * 112;
constexpr int CV_A = CV_ATT + CV_FFN, CV_F1 = CV_A + CV_ATT, CV_F2 = CV_F1 + CV_MOE, CV_F3 = CV_F2 + CV_ATT + CV_FFN, CV_F4 = CV_F3 + CV_ATT, CV_F5 = CV_F4 + CV_MOE, CV_END = CV_F5;
static_assert(CV_ATT == 2012 && CV_FFN == 4224 && CV_MOE == 43008 && CV_END == 102512, "conversion item counts");
struct CvtItem { const float* src; bf16_t* dst; const float* gain; int K, N, kind, k0, n0; };
__device__ __forceinline__ int cvt_row(int kind, int n) { return kind == 0 ? n : (kind == 1 ? (n < 1792 ? n : (n < 1824 ? n + 768 : n - 32)) : 8 * (n >> 2) + (kind == 3 ? 4 : 0) + (n & 3)); }
__device__ __forceinline__ CvtItem cvt_decode(int idx, kptr_t kp, GAS unsigned char* ws) {
#define CV_IN(i) ((const float*)(*(GAS const float* const __attribute__((address_space(4)))*)(kp + 8 * (i))))
#define CV_WS(off) ((bf16_t*)(GAS bf16_t*)(ws + (off)))
    CvtItem t; t.gain = nullptr; int r, g, L, q;
    if (idx < CV_ATT) { g = 0; L = 0; q = idx; } else if (idx < CV_A) { g = 1; L = 0; q = idx - CV_ATT; } else if (idx < CV_F1) { g = 0; L = 1; q = idx - CV_A; }
    else if (idx < CV_F2) { g = 2; L = 0; q = idx - CV_F1; } else if (idx < CV_F2 + CV_ATT) { g = 0; L = 2; q = idx - CV_F2; } else if (idx < CV_F3) { g = 1; L = 1; q = idx - CV_F2 - CV_ATT; }
    else if (idx < CV_F4) { g = 0; L = 3; q = idx - CV_F3; } else { g = 2; L = 1; q = idx - CV_F4; }
    if (g == 0) {
        if (q < 1296) { r = q; t.src = CV_IN(2) + (size_t)L * DM * IN_COLS; t.K = DM; t.N = IN_COLS; t.dst = CV_WS(WS_WIN) + (size_t)L * PJ * DM; t.kind = 1; t.gain = CV_IN(1) + (size_t)L * DM; }
        else if (q < 1404) { r = q - 1296; t.src = CV_IN(5) + (size_t)L * QLR * QUP; t.K = QLR; t.N = QUP; t.dst = CV_WS(WS_WUQ) + (size_t)L * QUP_PAD * QLR; t.kind = 0; t.gain = CV_IN(3) + (size_t)L * QLR; }
        else if (q < 1500) { r = q - 1404; t.src = CV_IN(6) + (size_t)L * KVLR * KVUP; t.K = KVLR; t.N = KVUP; t.dst = CV_WS(WS_WUKV) + (size_t)L * KVUP * KVLR; t.kind = 0; t.gain = CV_IN(4) + (size_t)L * KVLR; }
        else { r = q - 1500; t.src = CV_IN(11) + (size_t)L * DM * DM; t.K = DM; t.N = DM; t.dst = CV_WS(WS_WO) + (size_t)L * DM * DM; t.kind = 0; }
    } else if (g == 1) {
        const int tt = q / 1408; r = q % 1408;
        if (tt < 2) { t.src = CV_IN(tt == 0 ? 13 : 14) + (size_t)L * DM * DFF; t.K = DM; t.N = DFF; t.dst = CV_WS(WS_W13) + (size_t)L * 2 * DFF * DM; t.kind = 2 + tt; t.gain = CV_IN(12) + (size_t)(2 * L) * DM; }
        else { t.src = CV_IN(15) + (size_t)L * DFF * DM; t.K = DFF; t.N = DM; t.dst = CV_WS(WS_W2) + (size_t)L * DM * DFF; t.kind = 0; }
    } else {
        const int tt = q / 14336, mi = L * 8 + (q % 14336) / 1792; r = q % 1792;
        if (tt < 2) { t.src = CV_IN(tt == 0 ? 17 : 18) + (size_t)mi * DM * DFFE; t.K = DM; t.N = DFFE; t.dst = CV_WS(WS_EW13) + (size_t)mi * 2 * DFFE * DM; t.kind = 2 + tt; }
        else { t.src = CV_IN(19) + (size_t)mi * DFFE * DM; t.K = DFFE; t.N = DM; t.dst = CV_WS(WS_EW2) + (size_t)mi * DM * DFFE; t.kind = 0; }
    }
    const int nblk = t.N / 32; t.k0 = 64 * (r / nblk); t.n0 = 32 * (r % nblk); return t;
#undef CV_IN
#undef CV_WS
}
__device__ __forceinline__ void cvt_load(const CvtItem& t, float (&v)[32], int lane) {
#pragma unroll
    for (int i = 0; i < 32; ++i) v[i] = t.src[(size_t)(t.k0 + 2 * i + (lane >> 5)) * t.N + t.n0 + (lane & 31)];
}
__device__ __forceinline__ void cvt_store(const CvtItem& t, const float (&v)[32], LAS float* scr, int lane) {
#pragma unroll
    for (int i = 0; i < 32; ++i) scr[(2 * i + (lane >> 5)) * 33 + (lane & 31)] = v[i];
    LDS_WAIT(); asm volatile("" ::: "memory");
    const int c = lane & 7;
    f32x4 g0 = {1.f, 1.f, 1.f, 1.f}, g1 = g0;
    if (t.gain) { g0 = *(const f32x4*)(t.gain + t.k0 + 8 * c); g1 = *(const f32x4*)(t.gain + t.k0 + 8 * c + 4); }
#pragma unroll
    for (int j = 0; j < 4; ++j) { const int n = (lane >> 3) + 8 * j; const LAS float* s = scr + (8 * c) * 33 + n;
        u32x4 o; o.x = cvt_pk_bf16(s[0 * 33] * g0.x, s[1 * 33] * g0.y); o.y = cvt_pk_bf16(s[2 * 33] * g0.z, s[3 * 33] * g0.w); o.z = cvt_pk_bf16(s[4 * 33] * g1.x, s[5 * 33] * g1.y); o.w = cvt_pk_bf16(s[6 * 33] * g1.z, s[7 * 33] * g1.w);
        *(u32x4*)(t.dst + (size_t)cvt_row(t.kind, t.n0 + n) * t.K + t.k0 + 8 * c) = o; }
    LDS_WAIT(); asm volatile("" ::: "memory");
}
__device__ __forceinline__ void p_prologue(kptr_t kp, GAS unsigned char* ws, LAS unsigned char* lds, int gw, int NGW, int wave, int lane, int gtid, int NGT) {
    asm volatile("" : "+v"(lane), "+v"(gtid));
    LAS float* scr = (LAS float*)(lds + RING_OFF + wave * 16384);
    for (int it = gw; it < CV_END; it += NGW) { const CvtItem t = cvt_decode(it, kp, ws); float v[32]; cvt_load(t, v, lane); cvt_store(t, v, scr, lane); }
    bf16_t* WIN = (bf16_t*)(GAS bf16_t*)(ws + WS_WIN); bf16_t* WUQ = (bf16_t*)(GAS bf16_t*)(ws + WS_WUQ);
    const u32x4 z = {0u, 0u, 0u, 0u};
    for (int i = gtid; i < 4 * (PJ - IN_COLS) * DM / 8; i += NGT) { const int l = i / ((PJ - IN_COLS) * DM / 8), r = i % ((PJ - IN_COLS) * DM / 8); *(u32x4*)(WIN + ((size_t)l * PJ + IN_COLS) * DM + (size_t)r * 8) = z; }
    for (int i = gtid; i < 4 * (QUP_PAD - QUP) * QLR / 8; i += NGT) { const int l = i / ((QUP_PAD - QUP) * QLR / 8), r = i % ((QUP_PAD - QUP) * QLR / 8); *(u32x4*)(WUQ + ((size_t)l * QUP_PAD + QUP) * QLR + (size_t)r * 8) = z; }
}
struct MoeRow { i32x4 asg; f32x2 gate; };
template <int R, bool B16>
__device__ __forceinline__ void load_rows(f32x4 (&v)[R][4], const void* src, const int (&m)[R], int lane, bool combine, const i32x4* ASG, const f32x2* GATE, const float* YB, const LAS int* sbm) {
#pragma unroll
    for (int r = 0; r < R; ++r) {
        if constexpr (B16) { const u32x2* xr = (const u32x2*)((const bf16_t*)src + (size_t)m[r] * DM) + lane;
#pragma unroll
            for (int j = 0; j < 4; ++j) { const u32x2 w = xr[64 * j]; v[r][j] = (f32x4){bflo(w.x), bfhi(w.x), bflo(w.y), bfhi(w.y)}; } }
        else { const f32x4* xr = (const f32x4*)((const float*)src + (size_t)m[r] * DM) + lane;
#pragma unroll
            for (int j = 0; j < 4; ++j) v[r][j] = xr[64 * j]; } }
    if (combine) {
        i32x4 a[R]; f32x2 g[R]; const int tailrows = sbm[16]  ; const bf16_t* YBb = (const bf16_t*)YB; const bf16_t* YP = YBb + (WS_YP - WS_YB) / 2;
#pragma unroll
        for (int r = 0; r < R; ++r) { a[r] = ASG[m[r]]; g[r] = GATE[m[r]]; }
        f32x4 y0[R][4], y1[R][4];
#pragma unroll
        for (int r = 0; r < R; ++r) { const size_t r0 = (size_t)sbm[a[r].x] * 256 + a[r].y, r1 = (size_t)sbm[a[r].z] * 256 + a[r].w;
            const u32x2* p0 = (const u32x2*)(YBb + r0 * DM) + lane; const u32x2* p1 = (const u32x2*)(YBb + r1 * DM) + lane;
#pragma unroll
            for (int j = 0; j < 4; ++j) { const u32x2 w0 = p0[64 * j], w1 = p1[64 * j]; y0[r][j] = (f32x4){bflo(w0.x), bfhi(w0.x), bflo(w0.y), bfhi(w0.y)}; y1[r][j] = (f32x4){bflo(w1.x), bfhi(w1.x), bflo(w1.y), bfhi(w1.y)}; }
            if (r0 < (size_t)tailrows) { for (int q = 0; q < 3; ++q) { const u32x2* pp = (const u32x2*)(YP + ((size_t)q * 2048 + r0) * DM) + lane;
#pragma unroll
                for (int j = 0; j < 4; ++j) { const u32x2 w = pp[64 * j]; y0[r][j] += (f32x4){bflo(w.x), bfhi(w.x), bflo(w.y), bfhi(w.y)}; } } }
            if (r1 < (size_t)tailrows) { for (int q = 0; q < 3; ++q) { const u32x2* pp = (const u32x2*)(YP + ((size_t)q * 2048 + r1) * DM) + lane;
#pragma unroll
                for (int j = 0; j < 4; ++j) { const u32x2 w = pp[64 * j]; y1[r][j] += (f32x4){bflo(w.x), bfhi(w.x), bflo(w.y), bfhi(w.y)}; } } } }
#pragma unroll
        for (int r = 0; r < R; ++r)
#pragma unroll
            for (int j = 0; j < 4; ++j) v[r][j] = (v[r][j] + g[r].x * y0[r][j]) + g[r].y * y1[r][j];
    }
}
__device__ __forceinline__ float row_ss(const f32x4 (&v)[4]) {
    float s = 0.f;
#pragma unroll
    for (int j = 0; j < 4; ++j) s += (v[j].x * v[j].x + v[j].y * v[j].y) + (v[j].z * v[j].z + v[j].w * v[j].w);
    return s;
}
__device__ __forceinline__ float row_rstd(const f32x4 (&v)[4]) { return 1.0f / sqrtf(wave_sum(row_ss(v)) * (1.0f / DM) + RMS_EPS); }
template <int R, bool B16>
__device__ __forceinline__ void t_norm(const void* src, bf16_t* xdst, float* RS, int gw, int NGW, int lane, bool combine, const i32x4* ASG, const f32x2* GATE, const float* YB, const LAS int* sbm) {
    asm volatile("" : "+v"(lane));
    for (int m0 = gw; m0 < MTOK; m0 += R * NGW) {
        int m[R]; f32x4 v[R][4];
#pragma unroll
        for (int r = 0; r < R; ++r) m[r] = min(m0 + r * NGW, MTOK - 1);
        load_rows<R, B16>(v, src, m, lane, combine, ASG, GATE, YB, sbm);
#pragma unroll
        for (int r = 0; r < R; ++r) {
            const float rstd = row_rstd(v[r]);
            if (m0 + r * NGW < MTOK) {
                if (xdst) { u32x2* xo = (u32x2*)(xdst + (size_t)m[r] * DM) + lane;
#pragma unroll
                    for (int j = 0; j < 4; ++j) { u32x2 w; w.x = cvt_pk_bf16(v[r][j].x, v[r][j].y); w.y = cvt_pk_bf16(v[r][j].z, v[r][j].w); xo[64 * j] = w; } }
                if (lane == 0) RS[m[r]] = rstd;
            }
        }
    }
}
__device__ __forceinline__ void t_rs(const float* SS, float* RS, int bx, int G, int tid) {
    for (int m = bx + G * tid; m < MTOK; m += G * 512) { const f32x4* p = (const f32x4*)(SS + (size_t)m * 16); const f32x4 a = p[0], b = p[1], c = p[2], d = p[3];
        const float sq = (((a.x + a.y) + (a.z + a.w)) + ((b.x + b.y) + (b.z + b.w))) + (((c.x + c.y) + (c.z + c.w)) + ((d.x + d.y) + (d.z + d.w)));
        RS[m] = 1.0f / sqrtf(sq * (1.0f / DM) + RMS_EPS); }
}
template <bool B16>
__device__ __forceinline__ void t_final(const void* src, float* out, const float* gain, int gw, int NGW, int lane, bool combine, const i32x4* ASG, const f32x2* GATE, const float* YB, const LAS int* sbm) {
    asm volatile("" : "+v"(lane));
    constexpr int R = 2;
    f32x4 gg[4];
#pragma unroll
    for (int j = 0; j < 4; ++j) gg[j] = *((const f32x4*)gain + lane + 64 * j);
    for (int m0 = gw; m0 < MTOK; m0 += R * NGW) {
        int m[R]; f32x4 v[R][4];
#pragma unroll
        for (int r = 0; r < R; ++r) m[r] = min(m0 + r * NGW, MTOK - 1);
        load_rows<R, B16>(v, src, m, lane, combine, ASG, GATE, YB, sbm);
#pragma unroll
        for (int r = 0; r < R; ++r) {
            const float rstd = row_rstd(v[r]);
            if (m0 + r * NGW < MTOK) { f32x4* xo = (f32x4*)(out + (size_t)m[r] * DM) + lane;
#pragma unroll
                for (int j = 0; j < 4; ++j) xo[64 * j] = v[r][j] * rstd * gg[j]; }
        }
    }
}
__device__ __forceinline__ void t_mla_prep(const bf16_t* PROJ, const float* gq, const float* gkv, bf16_t* CQN, bf16_t* CKVN, bf16_t* KR, int gw, int NGW, int lane) {
    asm volatile("" : "+v"(lane));
    constexpr int R = 8;
    f32x4 gq0 = {0.f, 0.f, 0.f, 0.f}, gq1 = gq0, gk0 = gq0, gk1 = gq0;
    if (lane < 48) { gq0 = *(const f32x4*)(gq + 8 * lane); gq1 = *(const f32x4*)(gq + 8 * lane + 4); }
    if (lane < 32) { gk0 = *(const f32x4*)(gkv + 8 * lane); gk1 = *(const f32x4*)(gkv + 8 * lane + 4); }
    for (int m0 = gw; m0 < MTOK; m0 += R * NGW) {
        u32x4 a[R], b[R]; unsigned short k1[R], k2[R]; int m[R];
#pragma unroll
        for (int r = 0; r < R; ++r) { m[r] = min(m0 + r * NGW, MTOK - 1); const bf16_t* p = PROJ + (size_t)m[r] * PJ;
            a[r] = (u32x4){0u, 0u, 0u, 0u}; b[r] = a[r]; k1[r] = 0; k2[r] = 0;
            if (lane < 48) a[r] = *(const u32x4*)(p + PC_CQ + 8 * lane);
            if (lane < 32) b[r] = *(const u32x4*)(p + PC_CKV + 8 * lane);
            if (lane < 16) { k1[r] = p[PC_KR + lane]; k2[r] = p[PC_KR + 16 + lane]; } }
#pragma unroll
        for (int r = 0; r < R; ++r) {
            float fa[8], fb[8]; float sa = 0.f, sb = 0.f;
#pragma unroll
            for (int i = 0; i < 4; ++i) { fa[2 * i] = bflo(a[r][i]); fa[2 * i + 1] = bfhi(a[r][i]); fb[2 * i] = bflo(b[r][i]); fb[2 * i + 1] = bfhi(b[r][i]); }
#pragma unroll
            for (int i = 0; i < 8; ++i) { sa += fa[i] * fa[i]; sb += fb[i] * fb[i]; }
            const float ra = 1.0f / sqrtf(wave_sum(sa) * (1.0f / QLR) + RMS_EPS), rb = 1.0f / sqrtf(wave_sum(sb) * (1.0f / KVLR) + RMS_EPS);
            if (m0 + r * NGW < MTOK) {
                if (lane < 48) { u32x4 w;
                    w.x = cvt_pk_bf16(fa[0] * ra * gq0.x, fa[1] * ra * gq0.y); w.y = cvt_pk_bf16(fa[2] * ra * gq0.z, fa[3] * ra * gq0.w); w.z = cvt_pk_bf16(fa[4] * ra * gq1.x, fa[5] * ra * gq1.y); w.w = cvt_pk_bf16(fa[6] * ra * gq1.z, fa[7] * ra * gq1.w);
                    *(u32x4*)(CQN + (size_t)m[r] * QLR + 8 * lane) = w; }
                if (lane < 32) { u32x4 w;
                    w.x = cvt_pk_bf16(fb[0] * rb * gk0.x, fb[1] * rb * gk0.y); w.y = cvt_pk_bf16(fb[2] * rb * gk0.z, fb[3] * rb * gk0.w); w.z = cvt_pk_bf16(fb[4] * rb * gk1.x, fb[5] * rb * gk1.y); w.w = cvt_pk_bf16(fb[6] * rb * gk1.z, fb[7] * rb * gk1.w);
                    *(u32x4*)(CKVN + (size_t)m[r] * KVLR + 8 * lane) = w; }
                if (lane < 16) { const float x1 = bf2f(k1[r]), x2 = bf2f(k2[r]); float c, s; rope_cs(m[r] & (SEQ - 1), lane, c, s);
                    KR[(size_t)m[r] * 32 + lane] = (bf16_t)(cvt_pk_bf16(x1 * c - x2 * s, 0.f) & 0xffffu); KR[(size_t)m[r] * 32 + 16 + lane] = (bf16_t)(cvt_pk_bf16(x1 * s + x2 * c, 0.f) & 0xffffu); }
            }
        }
    }
}
__device__ __forceinline__ void t_mla_prep2(const bf16_t* PROJ, const float* SSL, float* RSQ, float* RSKV, bf16_t* KR, int gw, int NGW, int lane) {
    asm volatile("" : "+v"(lane));
    constexpr int R = 8;
    for (int m0 = gw; m0 < MTOK; m0 += R * NGW) {
        unsigned short k1[R], k2[R]; f32x4 sa[R], sb[R], sc[R]; int m[R];
#pragma unroll
        for (int r = 0; r < R; ++r) { m[r] = min(m0 + r * NGW, MTOK - 1); const bf16_t* p = PROJ + (size_t)m[r] * PJ; k1[r] = 0; k2[r] = 0;
            if (lane < 16) { k1[r] = p[PC_KR + lane]; k2[r] = p[PC_KR + 16 + lane]; }
            const f32x4* sp = (const f32x4*)(SSL + (size_t)m[r] * 16); sa[r] = sp[0]; sb[r] = sp[1]; sc[r] = sp[2]; }
#pragma unroll
        for (int r = 0; r < R; ++r) {
            if (m0 + r * NGW < MTOK) {
                if (lane == 32) { const float sq = ((sa[r].x + sa[r].y) + (sa[r].z + sa[r].w)) + ((sb[r].x + sb[r].y) + (sb[r].z + sb[r].w)), skv = (sc[r].x + sc[r].y) + (sc[r].z + sc[r].w);
                    RSQ[m[r]] = 1.0f / sqrtf(sq * (1.0f / QLR) + RMS_EPS); RSKV[m[r]] = 1.0f / sqrtf(skv * (1.0f / KVLR) + RMS_EPS); }
                if (lane < 16) { const float x1 = bf2f(k1[r]), x2 = bf2f(k2[r]); float c, s_; rope_cs(m[r] & (SEQ - 1), lane, c, s_);
                    KR[(size_t)m[r] * 32 + lane] = (bf16_t)(cvt_pk_bf16(x1 * c - x2 * s_, 0.f) & 0xffffu); KR[(size_t)m[r] * 32 + 16 + lane] = (bf16_t)(cvt_pk_bf16(x1 * s_ + x2 * c, 0.f) & 0xffffu); }
            }
        }
    }
}
__device__ __forceinline__ void t_post_attn(const bf16_t* OA, const f32x2* ML, const bf16_t* YC, const float* ga, const float* gb, const float* gc, bf16_t* YN, int gw, int NGW, int lane) {
    asm volatile("" : "+v"(lane));
    constexpr int R = 4;
    const bool lo = lane < 32;
    f32x4 gg[4];
#pragma unroll
    for (int j = 0; j < 4; ++j) { const int c = 4 * lane + 256 * j; const float* gp = (c < 384) ? (ga + c) : ((c < 768) ? (gb + c - 384) : (gc + c - 768)); gg[j] = *(const f32x4*)gp; }
    for (int m0 = gw; m0 < MTOK; m0 += R * NGW) {
        int m[R]; f32x2 ml[R][3][3]; u32x2 oa[R][3][3]; u32x2 yv[R];
#pragma unroll
        for (int r = 0; r < R; ++r) { m[r] = min(m0 + r * NGW, MTOK - 1);
#pragma unroll
            for (int j = 0; j < 3; ++j) { const int c = 4 * lane + 256 * j; const bool isA = c < 384; const int cp = isA ? c : c - 384, pb = isA ? 0 : 3, h = cp >> 6;
#pragma unroll
                for (int g = 0; g < 3; ++g) { const int part = pb + ((isA || g < 2) ? g : 1);
                    ml[r][j][g] = ML[((size_t)part * MTOK + m[r]) * 8 + h]; oa[r][j][g] = *(const u32x2*)(OA + ((size_t)part * MTOK + m[r]) * 384 + cp); } }
            yv[r] = *(const u32x2*)(YC + (size_t)m[r] * 256 + 4 * lane); }
#pragma unroll
        for (int r = 0; r < R; ++r) {
            f32x4 v[4];
#pragma unroll
            for (int j = 0; j < 3; ++j) {
                const int c = 4 * lane + 256 * j; const bool isA = c < 384;
                const float mx = fmaxf(fmaxf(ml[r][j][0].x, ml[r][j][1].x), ml[r][j][2].x);
                float w[3]; float ws_ = 0.f;
#pragma unroll
                for (int g = 0; g < 3; ++g) { w[g] = (isA || g < 2) ? ml[r][j][g].y * __expf(ml[r][j][g].x - mx) : 0.f; ws_ += w[g]; }
                const float rw = 1.0f / ws_; f32x4 acc = {0.f, 0.f, 0.f, 0.f};
#pragma unroll
                for (int g = 0; g < 3; ++g) { const u32x2 t = oa[r][j][g]; const float wg = w[g] * rw;
                    acc.x += wg * bflo(t.x); acc.y += wg * bfhi(t.x); acc.z += wg * bflo(t.y); acc.w += wg * bfhi(t.y); }
                v[j] = acc;
            }
            { const u32x2 t = yv[r]; v[3] = (f32x4){bflo(t.x), bfhi(t.x), bflo(t.y), bfhi(t.y)}; }
            float ss[4];
#pragma unroll
            for (int j = 0; j < 4; ++j) ss[j] = (v[j].x * v[j].x + v[j].y * v[j].y) + (v[j].z * v[j].z + v[j].w * v[j].w);
            const float sA = wave_sum(ss[0] + (lo ? ss[1] : 0.f)), sB = wave_sum((lo ? 0.f : ss[1]) + ss[2]), sC = wave_sum(ss[3]);
            const float rA = 1.0f / sqrtf(sA * (1.0f / 384.f) + RMS_EPS), rB = 1.0f / sqrtf(sB * (1.0f / 384.f) + RMS_EPS), rC = 1.0f / sqrtf(sC * (1.0f / 256.f) + RMS_EPS);
            if (m0 + r * NGW < MTOK) {
                u32x2* o8 = (u32x2*)(YN + (size_t)m[r] * DM) + lane;
#pragma unroll
                for (int j = 0; j < 4; ++j) { const int c = 4 * lane + 256 * j;
                    const float rr = (c < 384) ? rA : ((c < 768) ? rB : rC);
                    u32x2 w; w.x = cvt_pk_bf16(v[j].x * rr * gg[j].x, v[j].y * rr * gg[j].y); w.y = cvt_pk_bf16(v[j].z * rr * gg[j].z, v[j].w * rr * gg[j].w); o8[64 * j] = w; }
            }
        }
    }
}
__device__ __forceinline__ void t_norm_route(const bf16_t* X, const float* gain, const float* wr, bf16_t* XN, int* BCNT  , i32x4* ASG, f32x2* GATE,
                                             LAS unsigned char* lds, int wave, int lane) {
    asm volatile("" : "+v"(lane));
    LAS int* cntL = (LAS int*)(lds + MISC_OFF + 320);
    f32x4 wq[4][4][2], gg[4];
#pragma unroll
    for (int j = 0; j < 4; ++j) { gg[j] = *((const f32x4*)gain + lane + 64 * j);
#pragma unroll
        for (int i = 0; i < 4; ++i) { const f32x4* wp = (const f32x4*)(wr + (size_t)(4 * lane + 256 * j + i) * 8); wq[j][i][0] = wp[0]; wq[j][i][1] = wp[1]; } }
    for (int batch = blockIdx.x; batch < MTOK / 64; batch += gridDim.x) {
        int my_e0 = 0, my_e1 = 0; float my_g0 = 0.f, my_g1 = 0.f;
#pragma unroll 1
        for (int rg = 0; rg < 2; ++rg) {
        f32x4 xv[4][4];
#pragma unroll
        for (int r4 = 0; r4 < 4; ++r4) { const u32x2* xr = (const u32x2*)(X + (size_t)(batch * 64 + wave * 8 + rg * 4 + r4) * DM) + lane;
#pragma unroll
            for (int j = 0; j < 4; ++j) { const u32x2 w = xr[64 * j]; xv[r4][j] = (f32x4){bflo(w.x), bfhi(w.x), bflo(w.y), bfhi(w.y)}; } }
#pragma unroll
        for (int r4 = 0; r4 < 4; ++r4) {
            const int rr = rg * 4 + r4;
            const int m = batch * 64 + wave * 8 + rr;
            f32x4 v[4];
#pragma unroll
            for (int j = 0; j < 4; ++j) v[j] = xv[r4][j];
            const float rstd = row_rstd(v);
            float lg[8];
#pragma unroll
            for (int e = 0; e < 8; ++e) lg[e] = 0.f;
            u32x2* o8 = (u32x2*)(XN + (size_t)m * DM) + lane;
#pragma unroll
            for (int j = 0; j < 4; ++j) {
                const f32x4 hh = {v[j].x * rstd * gg[j].x, v[j].y * rstd * gg[j].y, v[j].z * rstd * gg[j].z, v[j].w * rstd * gg[j].w};
                u32x2 w; w.x = cvt_pk_bf16(hh.x, hh.y); w.y = cvt_pk_bf16(hh.z, hh.w); o8[64 * j] = w;
#pragma unroll
                for (int i = 0; i < 4; ++i) { const f32x4 w0 = wq[j][i][0], w1 = wq[j][i][1]; const float hv = hh[i];
                    lg[0] += hv * w0.x; lg[1] += hv * w0.y; lg[2] += hv * w0.z; lg[3] += hv * w0.w; lg[4] += hv * w1.x; lg[5] += hv * w1.y; lg[6] += hv * w1.z; lg[7] += hv * w1.w; } }
#pragma unroll
            for (int e = 0; e < 8; ++e) lg[e] = wave_sum(lg[e]);
            int e0 = 0; float l0 = lg[0];
#pragma unroll
            for (int e = 1; e < 8; ++e) if (lg[e] > l0) { l0 = lg[e]; e0 = e; }
            int e1 = -1; float l1 = -3.0e38f;
#pragma unroll
            for (int e = 0; e < 8; ++e) if (e != e0 && lg[e] > l1) { l1 = lg[e]; e1 = e; }
            const float ex = __expf(l1 - l0); const float g0 = 1.0f / (1.0f + ex), g1 = ex * g0;
            if (lane == rr) { my_e0 = e0; my_e1 = e1; my_g0 = g0; my_g1 = g1; }
        }
        }
        const bool valid = lane < 8;
        if (lane < 8) { const int m = batch * 64 + wave * 8 + lane; ASG[m] = (i32x4){my_e0, 0, my_e1, 0}; GATE[m] = (f32x2){my_g0, my_g1}; }
        int c = 0;
#pragma unroll
        for (int e = 0; e < 8; ++e) { const int ce = __popcll(__ballot(valid && my_e0 == e)) + __popcll(__ballot(valid && my_e1 == e)); if (lane == e) c = ce; }
        if (lane < 8) cntL[wave * 8 + lane] = c;
        __syncthreads();
        if (wave == 0 && lane < 8) { int tot = 0;
#pragma unroll
            for (int w = 0; w < 8; ++w) tot += cntL[w * 8 + lane];
            BCNT[batch * 8 + lane] = tot; }
        __syncthreads();
    }
}
__device__ __forceinline__ void t_assign(const int* BCNT, int* TOK, i32x4* ASG, LAS int* cntm, LAS int* sbm, LAS unsigned char* lds, int wave, int lane) {
    LAS int* baseL = (LAS int*)(lds + MISC_OFF + 256);
    constexpr int NB64 = MTOK / 64;
    if (wave == 0) { int tot = 0;
        for (int i = 0; i < NB64 / 8; ++i) tot += BCNT[lane + 64 * i];
        tot += __shfl_xor(tot, 8); tot += __shfl_xor(tot, 16); tot += __shfl_xor(tot, 32);
        if (lane < 8) cntm[lane] = tot; }
    for (int batch = blockIdx.x; batch < NB64; batch += gridDim.x) {
        if (wave == 0) {
            { int base = 0; for (int i = 0; i < NB64 / 8; ++i) { const int v = BCNT[lane + 64 * i]; base += ((lane >> 3) + 8 * i < batch) ? v : 0; }
              base += __shfl_xor(base, 8); base += __shfl_xor(base, 16); base += __shfl_xor(base, 32);
              if (lane < 8) baseL[lane] = base; }
            asm volatile("s_waitcnt lgkmcnt(0)" ::: "memory");
            const int m = batch * 64 + lane; const i32x4 a = ASG[m];
            const unsigned long long lt = (1ull << lane) - 1ull, le = lt | (1ull << lane);
            int rank0 = 0, rank1 = 0;
#pragma unroll
            for (int e = 0; e < 8; ++e) { const unsigned long long m0 = __ballot(a.x == e), m1 = __ballot(a.z == e); const int bs = baseL[e];
                if (a.x == e) rank0 = bs + __popcll(m0 & lt) + __popcll(m1 & lt);
                if (a.z == e) rank1 = bs + __popcll(m0 & le) + __popcll(m1 & lt); }
            TOK[a.x * 16384 + rank0] = m; TOK[a.z * 16384 + rank1] = m;
            ASG[m] = (i32x4){a.x, rank0, a.z, rank1};
        }
    }
    __syncthreads();
    if (threadIdx.x == 0) { int s = 0; for (int e = 0; e < 8; ++e) { sbm[e] = s; s += (cntm[e] + 255) >> 8; } }
    __syncthreads();
}


struct Args { const float* in[21]; float* out; unsigned char* ws; int nsub; int pad; };
#define PH_BEGIN() kptr_t kp_ = kp; GAS unsigned char* ws_ = (GAS unsigned char*)ws; asm volatile("" : "+s"(kp_), "+s"(ws_))
#define INP(i) ((const float*)(*(GAS const float* const __attribute__((address_space(4)))*)(kp_ + 8 * (i))))
#define WSP(T, off) ((T*)(GAS T*)(ws_ + (off)))
enum { I_X = 0, I_GMIX, I_WIN, I_GQ, I_GKV, I_WUQ, I_WUKV, I_RPB, I_GOA, I_GOB, I_GOC, I_WO, I_GFFN, I_W1, I_W3, I_W2, I_WR, I_EW1, I_EW3, I_EW2, I_GFIN };
#define TID ((int)threadIdx.x)
#define LANE ((int)threadIdx.x & 63)
#define GRID_BAR() xcd_barrier(bar)
template <int l> __device__ __forceinline__ void run_layer(const kptr_t kp, unsigned char* const ws, LAS unsigned char* const lds, const XcdBarrier& bar, const int G, const int bx, const int vcu, const int wave, const int nsub) {
    const int gw = vcu * 8 + wave, NGW = G * 8;
    LAS int* sbm = (LAS int*)(lds + MISC_OFF + 64);
    LAS int* cntm = (LAS int*)(lds + MISC_OFF + 96);
    if constexpr (l == 1 || l == 3) { PH_BEGIN(); t_rs(WSP(float, WS_XN)  , WSP(float, WS_RSTD), bx, G, TID); }
    else { PH_BEGIN(); bf16_t* X = WSP(bf16_t, WS_X); const bool pending = (l == 2);
      t_norm<(l == 2) ? 2 : 4, (l != 0)>(l == 0 ? (const void*)INP(I_X) : (const void*)X, (pending || l == 0) ? X : nullptr, WSP(float, WS_RSTD), gw, NGW, LANE, pending, WSP(i32x4, WS_ASG), WSP(f32x2, WS_GATE), WSP(float, WS_YB), sbm); }
    GRID_BAR();
    { PH_BEGIN(); pg8::Gemm g{WSP(bf16_t, WS_X), WSP(bf16_t, WS_WIN) + (size_t)l * PJ * DM, DM, nullptr, 0}; pg8::StaticOrder S; S.init(MTOK, PJ, G, bx);
      pg8::EpiBf16S E{WSP(bf16_t, WS_PROJ), PJ, WSP(float, WS_RSTD), WSP(float, WS_XN + 2 * MiB)  };
      pg8::gemm_phase<pg8::EpiBf16S, pg8::StaticOrder, true, false>(lds + RING_OFF, g, S, E); }
    GRID_BAR();
    { PH_BEGIN(); t_mla_prep2(WSP(bf16_t, WS_PROJ), WSP(float, WS_XN + 2 * MiB), WSP(float, WS_RSQ), WSP(float, WS_RSKV), WSP(bf16_t, WS_KR), gw, NGW, LANE); }
    GRID_BAR();
    { PH_BEGIN(); pg8::Gemm g{WSP(bf16_t, WS_PROJ) + PC_CQ, WSP(bf16_t, WS_WUQ) + (size_t)l * QUP_PAD * QLR, QLR, nullptr, PJ}; pg8::StaticOrder S; S.init(MTOK, QUP_PAD, G, bx);
      pg8::EpiBf16S E{WSP(bf16_t, WS_QB), QUP_PAD, WSP(float, WS_RSQ), nullptr};
      pg8::gemm_phase<pg8::EpiBf16S, pg8::StaticOrder, true, false, false, true>(lds + RING_OFF, g, S, E); }
    { PH_BEGIN(); pg8::Gemm g{WSP(bf16_t, WS_PROJ) + PC_CKV, WSP(bf16_t, WS_WUKV) + (size_t)l * KVUP * KVLR, KVLR, nullptr, PJ}; pg8::StaticOrder S; S.init(MTOK, KVUP, G, (bx + G / 2) % G);
      pg8::EpiBf16S E{WSP(bf16_t, WS_KVB), KVUP, WSP(float, WS_RSKV), nullptr};
      pg8::gemm_phase<pg8::EpiBf16S, pg8::StaticOrder, true, false, false, true>(lds + RING_OFF, g, S, E); }
    GRID_BAR();
    {
        LAS char* al = (LAS char*)(lds + RING_OFF);
        const int ub0 = (vcu * 768) / G, nb = ((vcu + 1) * 768) / G - ub0, ua0 = (vcu * 1152) / G, na = ((vcu + 1) * 1152) / G - ua0, uc0 = (vcu * 256) / G, nc = ((vcu + 1) * 256) / G - uc0;
#pragma unroll 1
        for (int k = 0; k < nb; ++k) { PH_BEGIN(); const int ub = ub0 + k, grp = ub >> 5, bh = grp >> 1; att::mla_unit(bh / 6, bh % 6, ub & 31, grp & 1, WSP(bf16_t, WS_QB), WSP(bf16_t, WS_KVB), WSP(bf16_t, WS_KR), WSP(bf16_t, WS_OA), WSP(f32x2, WS_ML), al); }
        { PH_BEGIN(); att::dil_phase(ua0, na, WSP(bf16_t, WS_PROJ), WSP(bf16_t, WS_OA), WSP(f32x2, WS_ML), al); }
        { PH_BEGIN(); att::nat_phase(uc0, nc, WSP(bf16_t, WS_PROJ), WSP(bf16_t, WS_Y), INP(I_RPB) + (size_t)l * 4 * 465, al); }
    }
    GRID_BAR();
    { PH_BEGIN(); t_post_attn(WSP(bf16_t, WS_OA), WSP(f32x2, WS_ML), WSP(bf16_t, WS_Y), INP(I_GOA) + l * 384, INP(I_GOB) + l * 384, INP(I_GOC) + l * 256, WSP(bf16_t, WS_YN), gw, NGW, LANE); }
    GRID_BAR();
    { PH_BEGIN(); pg8::Gemm g{WSP(bf16_t, WS_YN), WSP(bf16_t, WS_WO) + (size_t)l * DM * DM, DM, nullptr, 0}; pg8::StaticOrder S; S.init(MTOK, DM, G, bx);
      pg8::EpiResidB E{nullptr, WSP(bf16_t, WS_X), WSP(bf16_t, WS_X), DM, (l & 1) ? nullptr : WSP(float, WS_XN)};
      pg8::gemm_phase<pg8::EpiResidB, pg8::StaticOrder, true, false>(lds + RING_OFF, g, S, E); }
    GRID_BAR();
    if (2 * l + 1 >= nsub) return;
    const int j = l >> 1;
    if constexpr ((l & 1) == 0) {
        { PH_BEGIN(); t_rs(WSP(float, WS_XN), WSP(float, WS_RSTD), bx, G, TID); }
        GRID_BAR();
        { PH_BEGIN(); pg8::Gemm g{WSP(bf16_t, WS_X), WSP(bf16_t, WS_W13) + (size_t)j * 2 * DFF * DM, DM, nullptr, 0}; pg8::StaticOrder S; S.init(MTOK, 2 * DFF, G, bx);
          pg8::EpiSwiGLUS E{WSP(bf16_t, WS_H), DFF, WSP(float, WS_RSTD)};
          pg8::gemm_phase<pg8::EpiSwiGLUS, pg8::StaticOrder, true, false>(lds + RING_OFF, g, S, E); }
        GRID_BAR();
        { PH_BEGIN(); pg8::Gemm g{WSP(bf16_t, WS_H), WSP(bf16_t, WS_W2) + (size_t)j * DM * DFF, DFF, nullptr, 0}; pg8::StaticOrder S; S.init(MTOK, DM, G, bx);
          pg8::EpiResidB E{nullptr, WSP(bf16_t, WS_X), WSP(bf16_t, WS_X), DM, WSP(float, WS_XN)};
          pg8::gemm_phase<pg8::EpiResidB, pg8::StaticOrder, true, false>(lds + RING_OFF, g, S, E); }
        GRID_BAR();
    } else {
        { PH_BEGIN(); t_norm_route(WSP(bf16_t, WS_X), INP(I_GFFN) + l * DM, INP(I_WR) + (size_t)j * DM * 8, WSP(bf16_t, WS_XN), WSP(int, WS_CTL) + CW_CUR + j * 2048, WSP(i32x4, WS_ASG), WSP(f32x2, WS_GATE), lds, wave, LANE); }
        GRID_BAR();
        { PH_BEGIN(); t_assign(WSP(int, WS_CTL) + CW_CUR + j * 2048, WSP(int, WS_TOK) + (size_t)j * 8 * 16384, WSP(i32x4, WS_ASG), cntm, sbm, lds, wave, LANE); }
        GRID_BAR();
        const int NBm = sbm[7] + ((cntm[7] + 255) >> 8);
        { PH_BEGIN(); pg8::Gemm g{WSP(bf16_t, WS_XN), WSP(bf16_t, WS_EW13) + (size_t)j * 8 * 2 * DFFE * DM, DM, WSP(int, WS_TOK) + (size_t)j * 8 * 16384, 0}; pg8::MoeOrder S; S.init(cntm, 2 * DFFE, G, bx);
          pg8::EpiSwiGLU E{WSP(bf16_t, WS_H), DFFE};
          pg8::gemm_phase<pg8::EpiSwiGLU, pg8::MoeOrder, true, true>(lds + RING_OFF, g, S, E); }
        GRID_BAR();
        int pm0 = (((4 * NBm) % G) + 3) >> 2; if (pm0 > 8) pm0 = 0;
        if (TID == 0) sbm[16] = pm0 * 256;
        { PH_BEGIN(); pg8::Gemm g{WSP(bf16_t, WS_H), WSP(bf16_t, WS_EW2) + (size_t)j * 8 * DM * DFFE, DFFE, nullptr, 0}; pg8::MoeOrder S; S.init(cntm, DM, G, bx); S.skip_rows(pm0);
          pg8::EpiBf16 E{WSP(bf16_t, WS_YB), DM};
          pg8::gemm_phase<pg8::EpiBf16, pg8::MoeOrder, true, false>(lds + RING_OFF, g, S, E); }
        if (pm0 > 0) { PH_BEGIN(); pg8::Gemm g{WSP(bf16_t, WS_H), WSP(bf16_t, WS_EW2) + (size_t)j * 8 * DM * DFFE, DFFE / 4, nullptr, DFFE}; pg8::MoeTailOrder S; S.init(cntm, DM, G, bx, pm0);
          pg8::EpiQuarter E{WSP(bf16_t, WS_YB), WSP(bf16_t, WS_YP), (size_t)2048 * DM, DM};
          pg8::gemm_phase<pg8::EpiQuarter, pg8::MoeTailOrder, true, false, true>(lds + RING_OFF, g, S, E); }
        GRID_BAR();
    }
}
__global__ void __launch_bounds__(512, 2) mega_fwd(Args args) {
    extern __shared__ __attribute__((aligned(16))) unsigned char lds_[];
    LAS unsigned char* lds = (LAS unsigned char*)lds_;
    volatile LAS unsigned* MISC = (volatile LAS unsigned*)(lds + MISC_OFF);
    const int wave = __builtin_amdgcn_readfirstlane((int)threadIdx.x >> 6);
    const int G = gridDim.x, bx = blockIdx.x, vcu = (G % 8 == 0) ? (bx % 8) * (G / 8) + bx / 8 : bx;
    const int gw = vcu * 8 + wave, NGW = G * 8;
    const kptr_t kp = (kptr_t)__builtin_amdgcn_kernarg_segment_ptr();
    unsigned char* const ws = *(unsigned char* const __attribute__((address_space(4)))*)(kp + 176);
    const int nsub = *(const int __attribute__((address_space(4)))*)(kp + 184);
    LAS int* sbm = (LAS int*)(lds + MISC_OFF + 64);

    for (int u = TID; u < 192; u += 512) ((LAS unsigned*)(lds + MISC_OFF))[u] = 0u;
    __syncthreads();
    XcdBarrier bar = xcd_barrier_post((unsigned*)(ws + WS_CTL) + CW_BAR, MISC + 8);

    { PH_BEGIN(); p_prologue(kp_, ws_, lds, gw, NGW, wave, LANE, bx * 512 + TID, G * 512); }
    GRID_BAR();

    if (nsub > 0) run_layer<0>(kp, ws, lds, bar, G, bx, vcu, wave, nsub);
    if (nsub > 2) run_layer<1>(kp, ws, lds, bar, G, bx, vcu, wave, nsub);
    if (nsub > 4) run_layer<2>(kp, ws, lds, bar, G, bx, vcu, wave, nsub);
    if (nsub > 6) run_layer<3>(kp, ws, lds, bar, G, bx, vcu, wave, nsub);
    { PH_BEGIN(); float* out = (float*)(*(GAS float* const __attribute__((address_space(4)))*)(kp_ + 168));
      const bool pending = (nsub == 4 || nsub == 8);
      if (nsub == 0) t_final<false>(INP(I_X), out, INP(I_GFIN), gw, NGW, LANE, pending, WSP(i32x4, WS_ASG), WSP(f32x2, WS_GATE), WSP(float, WS_YB), sbm);
      else t_final<true>(WSP(bf16_t, WS_X), out, INP(I_GFIN), gw, NGW, LANE, pending, WSP(i32x4, WS_ASG), WSP(f32x2, WS_GATE), WSP(float, WS_YB), sbm); }
}

extern "C" void kernel_launch(void* const* d_in, const int* in_sizes, int n_in, void* d_out, int out_size, void* d_ws, size_t ws_size, hipStream_t stream) {
    static int grid = 0;
    if (grid == 0) {
        if (n_in != 21 || in_sizes[0] != MTOK * DM || out_size != MTOK * DM || ws_size < WS_END) {
            fprintf(stderr, "kernel_launch: built for 21 inputs, x/out of %d floats, >= %zu bytes of workspace; got n_in %d, in0 %d, out %d, ws %zu; nothing launched\n", MTOK * DM, (size_t)WS_END, n_in, n_in > 0 ? in_sizes[0] : -1, out_size, ws_size); grid = -1; return; }
        int dev = 0, cus = 0, per_cu = 0;
        if (hipGetDevice(&dev) != hipSuccess || hipDeviceGetAttribute(&cus, hipDeviceAttributeMultiprocessorCount, dev) != hipSuccess) { fprintf(stderr, "kernel_launch: device query failed\n"); grid = -1; return; }
        if (hipFuncSetAttribute((const void*)mega_fwd, hipFuncAttributeMaxDynamicSharedMemorySize, LDS_BYTES) != hipSuccess) { fprintf(stderr, "kernel_launch: hipFuncSetAttribute failed\n"); grid = -1; return; }
        if (hipOccupancyMaxActiveBlocksPerMultiprocessor(&per_cu, (const void*)mega_fwd, 512, LDS_BYTES) != hipSuccess || per_cu < 1)
            fprintf(stderr, "kernel_launch: note: occupancy query reports %d workgroups per CU\n", per_cu);
        (void)hipGetLastError();
        grid = cus;
    }
    if (grid < 0) return;
    if (hipMemsetAsync((char*)d_ws + WS_CTL, 0, CTL_ZERO_BYTES, stream) != hipSuccess) { fprintf(stderr, "kernel_launch: memset failed\n"); return; }
    Args a{};
    for (int i = 0; i < 21; ++i) a.in[i] = (const float*)d_in[i];
    a.out = (float*)d_out; a.ws = (unsigned char*)d_ws; a.nsub = DBG_NSUB; a.pad = 0;
    hipLaunchKernelGGL(mega_fwd, dim3(grid), dim3(512), LDS_BYTES, stream, a);
    const hipError_t le = hipPeekAtLastError();
    if (le != hipSuccess) fprintf(stderr, "kernel_launch: launch failed: %s\n", hipGetErrorName(le));
}
```

```cpp
#include <hip/hip_runtime.h>
#include <cstdio>
#include <cstdint>

#ifndef DBG_NSUB
#define DBG_NSUB 8
#endif

#define GAS __attribute__((address_space(1)))
#define LAS __attribute__((address_space(3)))
typedef unsigned short bf16_t;
typedef short bf16x8 __attribute__((ext_vector_type(8)));
typedef short s16x4 __attribute__((ext_vector_type(4)));
typedef float f32x2 __attribute__((ext_vector_type(2)));
typedef float f32x4 __attribute__((ext_vector_type(4)));
typedef float f32x16 __attribute__((ext_vector_type(16)));
typedef unsigned u32x2 __attribute__((ext_vector_type(2)));
typedef unsigned u32x4 __attribute__((ext_vector_type(4)));
typedef int i32x4 __attribute__((ext_vector_type(4)));

constexpr int DM = 1024, SEQ = 8192, MTOK = 16384, DEPTH = 4;
constexpr int PJ = 2816;
constexpr int PC_QA = 0, PC_KA = 384, PC_VA = 768, PC_CQ = 1152, PC_CKV = 1536, PC_QC = 1792, PC_KC = 2048, PC_VC = 2304, PC_KR = 2560;
constexpr int IN_COLS = 2592, QLR = 384, KVLR = 256, QUP = 576, QUP_PAD = 768, KVUP = 768;
constexpr int DFF = 2816, DFFE = 3584, NEXP = 8;
constexpr int MOE_ROWS = 34816;
constexpr float RMS_EPS = 1e-6f;

constexpr size_t MiB = 1u << 20;
constexpr size_t WS_CTL = 0, CTL_ZERO_BYTES = 2 * MiB;
constexpr size_t WS_TOK = 1 * MiB;
constexpr size_t WS_RSQ = 320 * 1024, WS_RSKV = 384 * 1024;
constexpr size_t WS_RSTD = 256 * 1024;
constexpr size_t WS_WIN = 4 * MiB, WS_WUQ = 26 * MiB, WS_WUKV = 29 * MiB, WS_WO = 31 * MiB, WS_W13 = 39 * MiB, WS_W2 = 61 * MiB, WS_EW13 = 72 * MiB, WS_EW2 = 296 * MiB;
constexpr size_t WS_X = 408 * MiB, WS_XN = 472 * MiB;
constexpr size_t WS_PROJ = 504 * MiB, WS_YN = 504 * MiB  , WS_CQN = 592 * MiB, WS_CKVN = 604 * MiB, WS_KR = 612 * MiB,
                 WS_QB = 613 * MiB, WS_KVB = 637 * MiB, WS_OA = 661 * MiB  , WS_Y = 721 * MiB  , WS_ML = 729 * MiB  ;
constexpr size_t WS_H = 504 * MiB;
constexpr size_t WS_YB = 742 * MiB, WS_ASG = 878 * MiB, WS_GATE = 878 * MiB + 512 * 1024, WS_YP = 880 * MiB  , WS_END = 892 * MiB;
static_assert(WS_WIN + (size_t)4 * PJ * DM * 2 <= WS_WUQ && WS_WUQ + (size_t)4 * QUP_PAD * QLR * 2 <= WS_WUKV && WS_WUKV + (size_t)4 * KVUP * KVLR * 2 <= WS_WO, "ws map 1");
static_assert(WS_WO + (size_t)4 * DM * DM * 2 <= WS_W13 && WS_W13 + (size_t)2 * 2 * DFF * DM * 2 <= WS_W2 && WS_W2 + (size_t)2 * DM * DFF * 2 <= WS_EW13, "ws map 2");
static_assert(WS_EW13 + (size_t)16 * 2 * DFFE * DM * 2 <= WS_EW2 && WS_EW2 + (size_t)16 * DM * DFFE * 2 <= WS_X && WS_X + (size_t)MTOK * DM * 4 <= WS_XN && WS_XN + (size_t)MTOK * DM * 2 <= WS_PROJ, "ws map 3");
static_assert(WS_PROJ + (size_t)MTOK * PJ * 2 <= WS_CQN && WS_CQN + (size_t)MTOK * QLR * 2 <= WS_CKVN && WS_CKVN + (size_t)MTOK * KVLR * 2 <= WS_KR && WS_KR + (size_t)MTOK * 32 * 2 <= WS_QB, "ws map 4");
static_assert(WS_QB + (size_t)MTOK * 768 * 2 <= WS_KVB && WS_KVB + (size_t)MTOK * 768 * 2 <= WS_OA && WS_OA + (size_t)5 * MTOK * 384 * 2 <= WS_Y && WS_Y + (size_t)MTOK * 256 * 2 <= WS_ML && WS_ML + (size_t)5 * MTOK * 8 * 8 <= WS_YB, "ws map 5");
static_assert(WS_H + (size_t)MOE_ROWS * DFFE * 2 <= WS_YB && WS_YB + (size_t)MOE_ROWS * DM * 4 <= WS_ASG && WS_GATE + (size_t)MTOK * 8 <= WS_END, "ws map 6");
constexpr int CW_TMO = 0, CW_BAR = 4096, CW_CUR = 8192  ;

#define LDS_WAIT() asm volatile("s_waitcnt lgkmcnt(0)" ::: "memory")
#define SBAR() __builtin_amdgcn_sched_barrier(0)
__device__ __forceinline__ unsigned cvt_pk_bf16(float lo, float hi) { unsigned r; asm volatile("v_cvt_pk_bf16_f32 %0, %1, %2" : "=v"(r) : "v"(lo), "v"(hi)); return r; }
__device__ __forceinline__ float bf2f(unsigned short b) { return __builtin_bit_cast(float, (unsigned)b << 16); }
__device__ __forceinline__ float bflo(unsigned w) { return __builtin_bit_cast(float, w << 16); }
__device__ __forceinline__ float bfhi(unsigned w) { return __builtin_bit_cast(float, w & 0xffff0000u); }
__device__ __forceinline__ float wave_sum(float v) {
#pragma unroll
    for (int o = 1; o < 64; o <<= 1) v += __shfl_xor(v, o);
    return v;
}
__device__ __forceinline__ void rope_cs(int pos, int j, float& c, float& s) {
    const float inv = exp2f(-(float)j * 0.83048202372184058696f);
    const float ang = (float)pos * inv;
    const double rev = (double)ang * 0.15915494309189533577;
    const float fr = (float)(rev - floor(rev));
    s = __builtin_amdgcn_sinf(fr); c = __builtin_amdgcn_cosf(fr);
}

namespace pg8 {
constexpr int BM = 256, BK = 64, HALF = 128, HTB = HALF * BK * 2, STAGE_BYTES = 8 * HTB, NXCD = 8, WGM = 4;
__host__ __device__ __forceinline__ int lds_byte(int r, int c) { const int st = (r >> 4) * 2 + (c >> 5), rr = r & 15, cc = c & 31, ob = rr * 64 + cc * 2; return st * 1024 + (ob ^ (((ob >> 9) & 1) << 5)); }
__host__ __device__ __forceinline__ void stage_rc(int b, int& R, int& C) { const int st = b / 1024, sb = b % 1024, swz = sb ^ (((sb >> 9) & 1) << 5); R = (st >> 1) * 16 + swz / 64; C = (st & 1) * 32 + (swz % 64) / 2; }
__host__ __device__ __forceinline__ int perm32(int rho) { const int n = rho >> 4, i = rho & 15; return 8 * (i >> 2) + 4 * n + (i & 3); }

struct Unit { int pm, pn, pnb, ar0, kc; };
struct Gemm { const bf16_t* A; const bf16_t* Bt; int K; const int* rowtab; int ld; };

struct StaticOrder {
    int nM, nN, nwg, G, c;
    __device__ void init(int M, int N, int G_, int c_) { nM = M / BM; nN = N / BM; nwg = nM * nN; G = G_; c = c_; }
    __device__ bool next(int i, Unit& u) const {
        const long L = (long)i * G + c; if (L >= nwg) return false;
        int wgid = (int)L; { const int q = nwg / NXCD, r = nwg % NXCD, xcd = wgid % NXCD, off = wgid / NXCD; wgid = (xcd < r ? xcd * (q + 1) : r * (q + 1) + (xcd - r) * q) + off; }
        const int nig = WGM * nN, gid = wgid / nig, fm = gid * WGM, gsz = (nM - fm) < WGM ? (nM - fm) : WGM;
        u.pm = fm + ((wgid % nig) % gsz); u.pn = (wgid % nig) / gsz; u.pnb = u.pn; u.ar0 = 0; u.kc = 0; return true;
    }
};
struct MoeOrder {
    StaticOrder so; int sb[9]; int rb0;
    __device__ void init(const LAS int* cnt, int N, int G_, int c_) {
        int s = 0;
#pragma unroll
        for (int e = 0; e < 8; ++e) { sb[e] = s; s += (cnt[e] + 255) >> 8; }
        sb[8] = s; so.nM = s; so.nN = N / BM; so.nwg = s * so.nN; so.G = G_; so.c = c_; rb0 = 0;
    }
    __device__ bool next(int i, Unit& u) const {
        if (!so.next(i, u)) return false;
        u.pm += rb0;
        int e = 0;
#pragma unroll
        for (int j = 1; j < 8; ++j) e += (u.pm >= sb[j]) ? 1 : 0;
        int sbe = sb[0];
#pragma unroll
        for (int j = 1; j < 8; ++j) sbe = (e == j) ? sb[j] : sbe;
        u.pnb = e * so.nN + u.pn; u.ar0 = e * 16384 + (u.pm - sbe) * 256; return true;
    }
    __device__ void skip_rows(int pm0) { so.nM -= pm0; so.nwg = so.nM * so.nN; rb0 = pm0; }
};
struct MoeTailOrder {
    MoeOrder mo; int nsub_;
    __device__ void init(const LAS int* cnt, int N, int G_, int c_, int pm0) { mo.init(cnt, N, G_, c_); nsub_ = pm0 * 16; }
    __device__ bool next(int i, Unit& u) const {
        const int idx = i * mo.so.G + mo.so.c; if (idx >= nsub_) return false;
        const int t = idx >> 2; u.pm = t >> 2; u.pn = t & 3; u.kc = idx & 3;
        int e = 0;
#pragma unroll
        for (int j = 1; j < 8; ++j) e += (u.pm >= mo.sb[j]) ? 1 : 0;
        u.pnb = e * mo.so.nN + u.pn; u.ar0 = 0; return true;
    }
};

struct EpiBf16 {
    static constexpr bool PERM = true, SCALE = false;
    bf16_t* O; int ldc;
    __device__ __forceinline__ void operator()(const f32x4 (&acc)[2][2][4][2], const Unit& u, int wr, int wc, int fr, int fq) const {
        const int row0 = u.pm * BM + wr * 64 + fr, col0 = u.pn * BM + wc * 32 + 8 * fq;
#pragma unroll
        for (int ai = 0; ai < 2; ++ai)
#pragma unroll
            for (int m = 0; m < 4; ++m) { bf16_t* rowp = O + (size_t)(row0 + ai * HALF + m * 16) * ldc + col0;
#pragma unroll
                for (int bj = 0; bj < 2; ++bj) { const f32x4 v0 = acc[ai][bj][m][0], v1 = acc[ai][bj][m][1];
                    u32x4 w; w.x = cvt_pk_bf16(v0[0], v0[1]); w.y = cvt_pk_bf16(v0[2], v0[3]); w.z = cvt_pk_bf16(v1[0], v1[1]); w.w = cvt_pk_bf16(v1[2], v1[3]);
                    *(u32x4*)(rowp + bj * HALF) = w; } }
    }
};
struct EpiBf16S {
    static constexpr bool PERM = true, SCALE = true;
    bf16_t* O; int ldc; const float* rs; float* SSL;
    __device__ __forceinline__ void pre(const Unit& u, int wr, int fr, float (&rsv)[8]) const {
#pragma unroll
        for (int i = 0; i < 8; ++i) rsv[i] = rs[u.pm * BM + wr * 64 + fr + (i >> 2) * HALF + (i & 3) * 16]; }
    __device__ __forceinline__ void operator()(const f32x4 (&acc)[2][2][4][2], const Unit& u, int wr, int wc, int fr, int fq, const float (&rsv)[8]) const {
        const int row0 = u.pm * BM + wr * 64 + fr, col0 = u.pn * BM + wc * 32 + 8 * fq;
        const bool lat = SSL != nullptr && u.pn >= 4 && u.pn <= 6;
#pragma unroll
        for (int ai = 0; ai < 2; ++ai)
#pragma unroll
            for (int m = 0; m < 4; ++m) { const int row = row0 + ai * HALF + m * 16; bf16_t* rowp = O + (size_t)row * ldc + col0; const float r = rsv[ai * 4 + m]; float ss = 0.f;
#pragma unroll
                for (int bj = 0; bj < 2; ++bj) { const f32x4 v0 = acc[ai][bj][m][0] * r, v1 = acc[ai][bj][m][1] * r;
                    if (bj == 1 || u.pn != 4) ss += ((v0[0] * v0[0] + v0[1] * v0[1]) + (v0[2] * v0[2] + v0[3] * v0[3])) + ((v1[0] * v1[0] + v1[1] * v1[1]) + (v1[2] * v1[2] + v1[3] * v1[3]));
                    u32x4 w; w.x = cvt_pk_bf16(v0[0], v0[1]); w.y = cvt_pk_bf16(v0[2], v0[3]); w.z = cvt_pk_bf16(v1[0], v1[1]); w.w = cvt_pk_bf16(v1[2], v1[3]);
                    *(u32x4*)(rowp + bj * HALF) = w; }
                if (lat) { ss += __shfl_xor(ss, 16); ss += __shfl_xor(ss, 32);
                    if (fq == 0) SSL[(size_t)row * 16 + (u.pn - 4) * 4 + wc] = ss; } }
    }
};
struct EpiSwiGLU {
    static constexpr bool PERM = true, SCALE = false;
    bf16_t* O; int ldc;
    __device__ __forceinline__ void operator()(const f32x4 (&acc)[2][2][4][2], const Unit& u, int wr, int wc, int fr, int fq) const {
        const int row0 = u.pm * BM + wr * 64 + fr, col0 = u.pn * (BM / 2) + wc * 16 + 4 * fq;
#pragma unroll
        for (int ai = 0; ai < 2; ++ai)
#pragma unroll
            for (int m = 0; m < 4; ++m) { bf16_t* rowp = O + (size_t)(row0 + ai * HALF + m * 16) * ldc + col0;
#pragma unroll
                for (int bj = 0; bj < 2; ++bj) { const f32x4 a = acc[ai][bj][m][0], b = acc[ai][bj][m][1]; float h[4];
#pragma unroll
                    for (int i = 0; i < 4; ++i) h[i] = a[i] * __builtin_amdgcn_rcpf(1.0f + __builtin_amdgcn_exp2f(-1.4426950408889634f * a[i])) * b[i];
                    u32x2 w; w.x = cvt_pk_bf16(h[0], h[1]); w.y = cvt_pk_bf16(h[2], h[3]);
                    *(u32x2*)(rowp + bj * (HALF / 2)) = w; } }
    }
};
struct EpiSwiGLUS {
    static constexpr bool PERM = true, SCALE = true;
    bf16_t* O; int ldc; const float* rs;
    __device__ __forceinline__ void pre(const Unit& u, int wr, int fr, float (&rsv)[8]) const {
#pragma unroll
        for (int i = 0; i < 8; ++i) rsv[i] = rs[u.pm * BM + wr * 64 + fr + (i >> 2) * HALF + (i & 3) * 16]; }
    __device__ __forceinline__ void operator()(const f32x4 (&acc)[2][2][4][2], const Unit& u, int wr, int wc, int fr, int fq, const float (&rsv)[8]) const {
        const int row0 = u.pm * BM + wr * 64 + fr, col0 = u.pn * (BM / 2) + wc * 16 + 4 * fq;
#pragma unroll
        for (int ai = 0; ai < 2; ++ai)
#pragma unroll
            for (int m = 0; m < 4; ++m) { bf16_t* rowp = O + (size_t)(row0 + ai * HALF + m * 16) * ldc + col0; const float r = rsv[ai * 4 + m];
#pragma unroll
                for (int bj = 0; bj < 2; ++bj) { const f32x4 a = acc[ai][bj][m][0] * r, b = acc[ai][bj][m][1] * r; float h[4];
#pragma unroll
                    for (int i = 0; i < 4; ++i) h[i] = a[i] * __builtin_amdgcn_rcpf(1.0f + __builtin_amdgcn_exp2f(-1.4426950408889634f * a[i])) * b[i];
                    u32x2 w; w.x = cvt_pk_bf16(h[0], h[1]); w.y = cvt_pk_bf16(h[2], h[3]);
                    *(u32x2*)(rowp + bj * (HALF / 2)) = w; } }
    }
};
struct EpiResid {
    static constexpr bool PERM = false, SCALE = false;
    const float* src; float* out; int ldc;
    __device__ __forceinline__ void operator()(const f32x4 (&acc)[2][2][4][2], const Unit& u, int wr, int wc, int fr, int fq) const {
        const int row0 = u.pm * BM + wr * 64 + fr, col0 = u.pn * BM + wc * 32 + 4 * fq;
#pragma unroll
        for (int ai = 0; ai < 2; ++ai)
#pragma unroll
            for (int m = 0; m < 4; ++m) { const size_t off = (size_t)(row0 + ai * HALF + m * 16) * ldc + col0;
#pragma unroll
                for (int bj = 0; bj < 2; ++bj)
#pragma unroll
                    for (int n = 0; n < 2; ++n) { f32x4 v = acc[ai][bj][m][n]; if (src) v += *(const f32x4*)(src + off + bj * HALF + n * 16); *(f32x4*)(out + off + bj * HALF + n * 16) = v; } }
    }
};

struct EpiResidB {
    static constexpr bool PERM = true, SCALE = false;
    const float* src32; const bf16_t* src16; bf16_t* out; int ldc; float* SS;
    __device__ __forceinline__ void operator()(const f32x4 (&acc)[2][2][4][2], const Unit& u, int wr, int wc, int fr, int fq) const {
        const int row0 = u.pm * BM + wr * 64 + fr, col0 = u.pn * BM + wc * 32 + 8 * fq;
#pragma unroll
        for (int ai = 0; ai < 2; ++ai)
#pragma unroll
            for (int m = 0; m < 4; ++m) { const int row = row0 + ai * HALF + m * 16; const size_t off = (size_t)row * ldc + col0; float ss = 0.f;
#pragma unroll
                for (int bj = 0; bj < 2; ++bj) { f32x4 v0 = acc[ai][bj][m][0], v1 = acc[ai][bj][m][1];
                    if (src32) { v0 += *(const f32x4*)(src32 + off + bj * HALF); v1 += *(const f32x4*)(src32 + off + bj * HALF + 4); }
                    else { const u32x4 x = *(const u32x4*)(src16 + off + bj * HALF);
                        v0 += (f32x4){bflo(x.x), bfhi(x.x), bflo(x.y), bfhi(x.y)}; v1 += (f32x4){bflo(x.z), bfhi(x.z), bflo(x.w), bfhi(x.w)}; }
                    ss += ((v0[0] * v0[0] + v0[1] * v0[1]) + (v0[2] * v0[2] + v0[3] * v0[3])) + ((v1[0] * v1[0] + v1[1] * v1[1]) + (v1[2] * v1[2] + v1[3] * v1[3]));
                    u32x4 w; w.x = cvt_pk_bf16(v0[0], v0[1]); w.y = cvt_pk_bf16(v0[2], v0[3]); w.z = cvt_pk_bf16(v1[0], v1[1]); w.w = cvt_pk_bf16(v1[2], v1[3]);
                    *(u32x4*)(out + off + bj * HALF) = w; }
                if (SS) { ss += __shfl_xor(ss, 16); ss += __shfl_xor(ss, 32);
                    if (fq == 0) SS[(size_t)row * 16 + u.pn * 4 + wc] = ss; } }
    }
};
struct EpiQuarter {
    static constexpr bool PERM = false, SCALE = false;
    bf16_t* out0; bf16_t* outq; size_t qstride; int ldc;
    __device__ __forceinline__ void operator()(const f32x4 (&acc)[2][2][4][2], const Unit& u, int wr, int wc, int fr, int fq) const {
        const int row0 = u.pm * BM + wr * 64 + fr, col0 = u.pn * BM + wc * 32 + 4 * fq;
        bf16_t* out = u.kc == 0 ? out0 : outq + (size_t)(u.kc - 1) * qstride;
#pragma unroll
        for (int ai = 0; ai < 2; ++ai)
#pragma unroll
            for (int m = 0; m < 4; ++m) { const size_t off = (size_t)(row0 + ai * HALF + m * 16) * ldc + col0;
#pragma unroll
                for (int bj = 0; bj < 2; ++bj)
#pragma unroll
                    for (int n = 0; n < 2; ++n) { const f32x4 a = acc[ai][bj][m][n]; u32x2 w; w.x = cvt_pk_bf16(a.x, a.y); w.y = cvt_pk_bf16(a.z, a.w); *(u32x2*)(out + off + bj * HALF + n * 16) = w; } }
    }
};

template <class Epi, class Sched, bool ALIGN_EPI, bool GATHER, bool KSPLIT = false, bool APITCH = false>
__device__ __forceinline__ void gemm_phase(LAS unsigned char* lds, const Gemm g, const Sched& S, const Epi& E) {
    int tid = threadIdx.x; asm volatile("" : "+v"(tid));
    const int wid = __builtin_amdgcn_readfirstlane(tid >> 6), lane = tid & 63, wr = wid >> 2, wc = wid & 3, fr = lane & 15, fq = lane >> 4;
    const int K = g.K, nt = K / BK, LDA = (KSPLIT || APITCH) ? g.ld : K, LDB = KSPLIT ? g.ld : K;
    unsigned voffA[2], voffB[2]; unsigned CA2[2];
#pragma unroll
    for (int i = 0; i < 2; ++i) { int R, C; stage_rc(tid * 16 + i * 8192, R, C); const int Rb = Epi::PERM ? ((R & ~31) + perm32(R & 31)) : R;
        voffA[i] = (unsigned)(R * LDA + C) * 2u; voffB[i] = (unsigned)(Rb * LDB + C) * 2u; CA2[i] = (unsigned)C * 2u; }
    const size_t kstep = (size_t)(BK * 2);
    const size_t hstepA = (size_t)HALF * LDA * 2, hstepB = (size_t)HALF * LDB * 2;
    const size_t tstepA = 2 * hstepA, tstepB = 2 * hstepB;
    const unsigned ldsw = (unsigned)wid * 1024u;
    const int aoff = lds_byte(wr * 64 + fr, fq * 8), boff = lds_byte(wc * 32 + fr, fq * 8);
#define PG8_SA(b, h) (((b) * 2 + (h)) * HTB)
#define PG8_SB(b, h) ((4 + (b) * 2 + (h)) * HTB)
#define PG8_STAGE(bufoff, gbase, voff) do { _Pragma("unroll") for (int _i = 0; _i < 2; ++_i) \
        __builtin_amdgcn_global_load_lds((const unsigned*)((const char*)(gbase) + (voff)[_i]), (LAS unsigned*)(lds + (bufoff) + ldsw + _i * 8192), 16, 0, 0); } while (0)
#define PG8_LDA(dst, b, h) do { _Pragma("unroll") for (int m = 0; m < 4; ++m) _Pragma("unroll") for (int k = 0; k < 2; ++k) dst[m][k] = *(const LAS bf16x8*)(lds + PG8_SA(b, h) + aoff + m * 2048 + k * 1024); } while (0)
#define PG8_LDB(dst, b, h) do { _Pragma("unroll") for (int n = 0; n < 2; ++n) _Pragma("unroll") for (int k = 0; k < 2; ++k) dst[n][k] = *(const LAS bf16x8*)(lds + PG8_SB(b, h) + boff + n * 2048 + k * 1024); } while (0)
#define PG8_MMA(ai, bj, At, Bt) do { __builtin_amdgcn_s_setprio(1); _Pragma("unroll") for (int m = 0; m < 4; ++m) _Pragma("unroll") for (int n = 0; n < 2; ++n) _Pragma("unroll") for (int k = 0; k < 2; ++k) \
        acc[ai][bj][m][n] = __builtin_amdgcn_mfma_f32_16x16x32_bf16(Bt[n][k], At[m][k], acc[ai][bj][m][n], 0, 0, 0); __builtin_amdgcn_s_setprio(0); } while (0)
#define PG8_WAIT_V(n) asm volatile("s_waitcnt vmcnt(" #n ")" ::: "memory")
#define PG8_WAIT_L(n) asm volatile("s_waitcnt lgkmcnt(" #n ")" ::: "memory")
#define PG8_BAR __builtin_amdgcn_s_barrier()
#define PG8_STAGE_A(buf, h, p, usenext) do { if constexpr (GATHER) { const unsigned _t = (usenext) ? tkn[h] : tkc[h]; unsigned _v[2]; _v[0] = (_t & 0xffffu) * rowb + CA2[0]; _v[1] = (_t >> 16) * rowb + CA2[1]; PG8_STAGE(PG8_SA(buf, h), p, _v); } \
        else { PG8_STAGE(PG8_SA(buf, h), (p) + (h) * hstepA, voffA); } } while (0)
    Unit cur, nxt; int ui = 0;
    if (!S.next(0, cur)) return;
    f32x4 acc[2][2][4][2];
#pragma unroll
    for (int a = 0; a < 2; ++a)
#pragma unroll
        for (int b = 0; b < 2; ++b)
#pragma unroll
            for (int m = 0; m < 4; ++m)
#pragma unroll
                for (int n = 0; n < 2; ++n) acc[a][b][m][n] = (f32x4){0.f, 0.f, 0.f, 0.f};
    bf16x8 At[4][2], B0[2][2], B1[2][2];
    unsigned tkc[2], tkn[2];
    const unsigned rowb = (unsigned)LDA * 2u;
#define PG8_TOKS(dst, u_) do { int _R0, _R1, _C; stage_rc(tid * 16, _R0, _C); stage_rc(tid * 16 + 8192, _R1, _C); _Pragma("unroll") for (int h = 0; h < 2; ++h) dst[h] = (unsigned)g.rowtab[(u_).ar0 + h * HALF + _R0] | ((unsigned)g.rowtab[(u_).ar0 + h * HALF + _R1] << 16); } while (0)
    if constexpr (GATHER) {
        PG8_TOKS(tkc, cur); tkn[0] = 0u; tkn[1] = 0u;
        Unit n1; if (S.next(1, n1)) PG8_TOKS(tkn, n1);
    }
    const char* cA = GATHER ? (const char*)g.A : (const char*)g.A + (size_t)cur.pm * tstepA; const char* cB = (const char*)g.Bt + (size_t)cur.pnb * tstepB;
    if constexpr (KSPLIT) { cA += (size_t)cur.kc * K * 2; cB += (size_t)cur.kc * K * 2; }
    PG8_STAGE(PG8_SB(0, 0), cB, voffB); PG8_STAGE(PG8_SB(0, 1), cB + hstepB, voffB); PG8_STAGE_A(0, 0, cA, false); PG8_STAGE_A(0, 1, cA, false);
    if (wr == 1) PG8_BAR;
    PG8_WAIT_V(2); PG8_BAR;
    PG8_STAGE(PG8_SB(1, 0), cB + kstep, voffB); PG8_STAGE_A(1, 0, cA + kstep, false); PG8_STAGE(PG8_SB(1, 1), cB + hstepB + kstep, voffB);
    PG8_WAIT_V(6); PG8_BAR;
    float rsv[8];
    for (;;) {
        const bool has_next = S.next(ui + 1, nxt);
        if constexpr (Epi::SCALE) E.pre(cur, wr, fr, rsv);
        if constexpr (GATHER) {
            asm volatile("" : "+v"(tkn[0]), "+v"(tkn[1]));
        }
        const char* nA = GATHER ? cA : (has_next ? (const char*)g.A + (size_t)nxt.pm * tstepA : cA); const char* nB = has_next ? (const char*)g.Bt + (size_t)nxt.pnb * tstepB : cB;
        if constexpr (KSPLIT) { if (has_next) { nA += (size_t)nxt.kc * K * 2; nB += (size_t)nxt.kc * K * 2; } }
        for (int t = 0; t < nt; t += 2) {
            const bool last = (t == nt - 2);
            const bool un = last && has_next;
            const char* a1 = cA + (size_t)(t + 1) * kstep;
            const char* a2 = last ? nA : cA + (size_t)(t + 2) * kstep; const char* b2 = last ? nB : cB + (size_t)(t + 2) * kstep;
            const char* a3 = a2 + kstep; const char* b3 = b2 + kstep;
            PG8_LDB(B0, 0, 0); PG8_LDB(B1, 0, 1); SBAR(); PG8_LDA(At, 0, 0); PG8_STAGE_A(1, 1, a1, false);
            PG8_WAIT_V(8); PG8_WAIT_L(0); PG8_BAR; PG8_MMA(0, 0, At, B0); PG8_MMA(0, 1, At, B1); PG8_BAR; SBAR();
            PG8_LDA(At, 0, 1); PG8_STAGE(PG8_SB(0, 0), b2, voffB); PG8_STAGE(PG8_SB(0, 1), b2 + hstepB, voffB); PG8_STAGE_A(0, 0, a2, un);
            PG8_WAIT_V(8); PG8_WAIT_L(0); PG8_BAR; PG8_MMA(1, 0, At, B0); PG8_MMA(1, 1, At, B1); PG8_BAR; SBAR();
            PG8_LDB(B0, 1, 0); PG8_LDB(B1, 1, 1); SBAR(); PG8_LDA(At, 1, 0); PG8_STAGE_A(0, 1, a2, un);
            PG8_WAIT_V(8); PG8_WAIT_L(0); PG8_BAR; PG8_MMA(0, 0, At, B0); PG8_MMA(0, 1, At, B1); PG8_BAR; SBAR();
            PG8_LDA(At, 1, 1); PG8_STAGE(PG8_SB(1, 0), b3, voffB); PG8_STAGE(PG8_SB(1, 1), b3 + hstepB, voffB); PG8_STAGE_A(1, 0, a3, un);
            PG8_WAIT_V(8); PG8_WAIT_L(0); PG8_BAR; PG8_MMA(1, 0, At, B0); PG8_MMA(1, 1, At, B1); PG8_BAR; SBAR();
        }
        if constexpr (ALIGN_EPI) { if (wr == 0) PG8_BAR; }
        if constexpr (Epi::SCALE) E(acc, cur, wr, wc, fr, fq, rsv); else E(acc, cur, wr, wc, fr, fq);
        if (!has_next) break;
#pragma unroll
        for (int a = 0; a < 2; ++a)
#pragma unroll
            for (int b = 0; b < 2; ++b)
#pragma unroll
                for (int m = 0; m < 4; ++m)
#pragma unroll
                    for (int n = 0; n < 2; ++n) acc[a][b][m][n] = (f32x4){0.f, 0.f, 0.f, 0.f};
        cur = nxt; cA = nA; cB = nB; ++ui;
        if constexpr (GATHER) {
            tkc[0] = tkn[0]; tkc[1] = tkn[1];
            Unit n2; if (S.next(ui + 1, n2)) PG8_TOKS(tkn, n2);
        }
        if constexpr (ALIGN_EPI) { if (wr == 1) PG8_BAR; }
    }
    PG8_WAIT_V(0);
    if constexpr (!ALIGN_EPI) { if (wr == 0) PG8_BAR; }
    PG8_BAR;
#undef PG8_SA
#undef PG8_SB
#undef PG8_STAGE
#undef PG8_STAGE_A
#undef PG8_TOKS
#undef PG8_LDA
#undef PG8_LDB
#undef PG8_MMA
#undef PG8_WAIT_V
#undef PG8_WAIT_L
#undef PG8_BAR
}
}

namespace att {
constexpr int SHM_K = 64 * 256, SHM_V = 64 * 64 * 2;
constexpr int L_K = 0, L_V = 2 * SHM_K, L_WS = L_V + 2 * SHM_V, L_RPB = L_WS + 8 * 256, L_END = L_RPB + 2048;
#define KSWZ(row, colB) ((row) * 256 + ((colB) ^ (((row) & 15) << 4)))
__device__ __forceinline__ int crow(int r, int hi) { return (r & 3) + 8 * (r >> 2) + 4 * hi; }
__device__ __forceinline__ int v_st(int k, int c) { const int kk = (k & ~0xC) | ((k & 4) << 1) | ((k & 8) >> 1); return ((kk >> 3) * 2 + (c >> 5)) * 512 + ((kk & 7) * 32 + (c & 31)) * 2; }
__device__ __forceinline__ int v_rd_base(int lane) { return ((lane & 3) << 3) | (((lane >> 2) & 3) << 6) | (((lane >> 4) & 1) << 5) | (((lane >> 5) & 1) << 8); }
constexpr int v_rd_off(int d0, int ks, int half) { return d0 * 512 + ks * 2048 + half * 1024; }
template <int OFF> __device__ __forceinline__ s16x4 tr_read(int vb) { s16x4 r; asm volatile("ds_read_b64_tr_b16 %0, %1 offset:%2" : "=&v"(r) : "v"(vb), "i"(OFF) : "memory"); return r; }

__device__ __forceinline__ void partialSM(f32x16& p0, f32x16& p1, float& m_reg, float& mn, float& alpha, const float C, const float THRR) {
  float ma = fmaxf(fmaxf(p0[0], p0[1]), p0[2]), mb = fmaxf(fmaxf(p1[0], p1[1]), p1[2]);
#pragma unroll
  for (int r = 3; r < 15; r += 2) { ma = fmaxf(fmaxf(ma, p0[r]), p0[r + 1]); mb = fmaxf(fmaxf(mb, p1[r]), p1[r + 1]); }
  float pmax = fmaxf(fmaxf(ma, p0[15]), fmaxf(mb, p1[15]));
  if (__builtin_expect(__all(pmax - m_reg <= THRR), 1)) { mn = m_reg; alpha = 1.f; }
  else { { auto rr = __builtin_amdgcn_permlane32_swap(__float_as_uint(pmax), __float_as_uint(pmax), false, false);
           pmax = fmaxf(__uint_as_float(rr[0]), __uint_as_float(rr[1])); }
    mn = fmaxf(m_reg, pmax); alpha = __builtin_amdgcn_exp2f((m_reg - mn) * C); m_reg = mn; }
  const float mnC = -mn * C;
#pragma unroll
  for (int r = 0; r < 16; ++r) p0[r] = fmaf(p0[r], C, mnC);
#pragma unroll
  for (int r = 0; r < 16; ++r) p1[r] = fmaf(p1[r], C, mnC);
#pragma unroll
  for (int r = 0; r < 16; ++r) p0[r] = __builtin_amdgcn_exp2f(p0[r]);
}
__device__ __forceinline__ void finishSM(f32x16& p0, f32x16& p1, float alpha, float& l_reg, bf16x8& pa0, bf16x8& pa1, bf16x8& pa2, bf16x8& pa3) {
#pragma unroll
  for (int r = 0; r < 16; ++r) p1[r] = __builtin_amdgcn_exp2f(p1[r]);
  float s0 = p0[0], s1 = p0[8], s2 = p1[0], s3 = p1[8];
#pragma unroll
  for (int r = 1; r < 8; ++r) { s0 += p0[r]; s1 += p0[8 + r]; s2 += p1[r]; s3 += p1[8 + r]; }
  float ps = (s0 + s1) + (s2 + s3);
  { auto rr = __builtin_amdgcn_permlane32_swap(__float_as_uint(ps), __float_as_uint(ps), false, false);
    ps = __uint_as_float(rr[0]) + __uint_as_float(rr[1]); }
  l_reg = l_reg * alpha + ps;
#define PK4(P, BASE, OUT) do { unsigned a0 = cvt_pk_bf16(P[BASE + 0], P[BASE + 1]), a1 = cvt_pk_bf16(P[BASE + 2], P[BASE + 3]);   \
    unsigned b0 = cvt_pk_bf16(P[BASE + 4], P[BASE + 5]), b1 = cvt_pk_bf16(P[BASE + 6], P[BASE + 7]);                              \
    auto r0 = __builtin_amdgcn_permlane32_swap(a0, b0, false, false); auto r1 = __builtin_amdgcn_permlane32_swap(a1, b1, false, false); \
    u32x4 w = {r0[0], r1[0], r0[1], r1[1]}; OUT = __builtin_bit_cast(bf16x8, w); } while (0)
  PK4(p0, 0, pa0); PK4(p0, 8, pa1); PK4(p1, 0, pa2); PK4(p1, 8, pa3);
#undef PK4
}
__device__ __forceinline__ void maskedSM(f32x16& p0, f32x16& p1, unsigned vm0, unsigned vm1, float& m_reg, float& alpha, const float C, const float THRR) {
  float pmax = p0[0];
#pragma unroll
  for (int r = 1; r < 16; ++r) pmax = fmaxf(pmax, p0[r]);
#pragma unroll
  for (int r = 0; r < 16; ++r) pmax = fmaxf(pmax, p1[r]);
  { auto rr = __builtin_amdgcn_permlane32_swap(__float_as_uint(pmax), __float_as_uint(pmax), false, false);
    pmax = fmaxf(__uint_as_float(rr[0]), __uint_as_float(rr[1])); }
  float mn;
  if (__builtin_expect(__all(pmax - m_reg <= THRR), 1)) { mn = m_reg; alpha = 1.f; }
  else { mn = fmaxf(m_reg, pmax); alpha = __builtin_amdgcn_exp2f((m_reg - mn) * C); m_reg = mn; }
  const float mnC = -mn * C;
#pragma unroll
  for (int r = 0; r < 16; ++r) { const float e0 = __builtin_amdgcn_exp2f(fmaf(p0[r], C, mnC)), e1 = __builtin_amdgcn_exp2f(fmaf(p1[r], C, mnC));
    p0[r] = ((vm0 >> r) & 1u) ? e0 : 0.f; p1[r] = ((vm1 >> r) & 1u) ? e1 : 0.f; }
}
__device__ __forceinline__ void packSM(const f32x16& p0, const f32x16& p1, float alpha, float& l_reg, bf16x8& pa0, bf16x8& pa1, bf16x8& pa2, bf16x8& pa3) {
  float ps = 0;
#pragma unroll
  for (int r = 0; r < 16; ++r) ps += p0[r];
#pragma unroll
  for (int r = 0; r < 16; ++r) ps += p1[r];
  { auto rr = __builtin_amdgcn_permlane32_swap(__float_as_uint(ps), __float_as_uint(ps), false, false);
    ps = __uint_as_float(rr[0]) + __uint_as_float(rr[1]); }
  l_reg = l_reg * alpha + ps;
#define PK4(P, BASE, OUT) do { unsigned a0 = cvt_pk_bf16(P[BASE + 0], P[BASE + 1]), a1 = cvt_pk_bf16(P[BASE + 2], P[BASE + 3]);   \
    unsigned b0 = cvt_pk_bf16(P[BASE + 4], P[BASE + 5]), b1 = cvt_pk_bf16(P[BASE + 6], P[BASE + 7]);                              \
    auto r0 = __builtin_amdgcn_permlane32_swap(a0, b0, false, false); auto r1 = __builtin_amdgcn_permlane32_swap(a1, b1, false, false); \
    u32x4 w = {r0[0], r1[0], r0[1], r1[1]}; OUT = __builtin_bit_cast(bf16x8, w); } while (0)
  PK4(p0, 0, pa0); PK4(p0, 8, pa1); PK4(p1, 0, pa2); PK4(p1, 8, pa3);
#undef PK4
}
template <int NKS> __device__ __forceinline__ void qkt(f32x16& p0, f32x16& p1, const LAS char* Ks, const bf16x8* qr, int r32, int hi) {
  p0 = f32x16{}; p1 = f32x16{};
#pragma unroll
  for (int d0 = 0; d0 < NKS; ++d0) { const int cb = (d0 * 16 + hi * 8) * 2;
    const bf16x8 b0 = *(const LAS bf16x8*)(Ks + KSWZ(r32, cb));
    const bf16x8 b1 = *(const LAS bf16x8*)(Ks + KSWZ(32 + r32, cb));
    p0 = __builtin_amdgcn_mfma_f32_32x32x16_bf16(b0, qr[d0], p0, 0, 0, 0);
    p1 = __builtin_amdgcn_mfma_f32_32x32x16_bf16(b1, qr[d0], p1, 0, 0, 0); }
}
template <int D0> __device__ __forceinline__ void pv_one(f32x16& od, int vb, bf16x8 pa0, bf16x8 pa1, bf16x8 pa2, bf16x8 pa3) {
  const s16x4 l0 = tr_read<v_rd_off(D0, 0, 0)>(vb), h0 = tr_read<v_rd_off(D0, 0, 1)>(vb), l1 = tr_read<v_rd_off(D0, 1, 0)>(vb), h1 = tr_read<v_rd_off(D0, 1, 1)>(vb);
  const s16x4 l2 = tr_read<v_rd_off(D0, 2, 0)>(vb), h2 = tr_read<v_rd_off(D0, 2, 1)>(vb), l3 = tr_read<v_rd_off(D0, 3, 0)>(vb), h3 = tr_read<v_rd_off(D0, 3, 1)>(vb);
  asm volatile("s_waitcnt lgkmcnt(0)" ::: "memory"); SBAR();
#define PK(L, H) (bf16x8){L[0], L[1], L[2], L[3], H[0], H[1], H[2], H[3]}
  od = __builtin_amdgcn_mfma_f32_32x32x16_bf16(pa0, PK(l0, h0), od, 0, 0, 0);
  od = __builtin_amdgcn_mfma_f32_32x32x16_bf16(pa1, PK(l1, h1), od, 0, 0, 0);
  od = __builtin_amdgcn_mfma_f32_32x32x16_bf16(pa2, PK(l2, h2), od, 0, 0, 0);
  od = __builtin_amdgcn_mfma_f32_32x32x16_bf16(pa3, PK(l3, h3), od, 0, 0, 0);
#undef PK
}
__device__ __forceinline__ void pv2(f32x16* o, int vb, bf16x8 pa0, bf16x8 pa1, bf16x8 pa2, bf16x8 pa3) { pv_one<0>(o[0], vb, pa0, pa1, pa2, pa3); pv_one<1>(o[1], vb, pa0, pa1, pa2, pa3); }
__device__ __forceinline__ void pv2b(f32x16* o, int vb, bf16x8 pa0, bf16x8 pa1, bf16x8 pa2, bf16x8 pa3) {
  const s16x4 a0 = tr_read<v_rd_off(0, 0, 0)>(vb), b0 = tr_read<v_rd_off(0, 0, 1)>(vb), a1 = tr_read<v_rd_off(0, 1, 0)>(vb), b1 = tr_read<v_rd_off(0, 1, 1)>(vb);
  const s16x4 a2 = tr_read<v_rd_off(0, 2, 0)>(vb), b2 = tr_read<v_rd_off(0, 2, 1)>(vb), a3 = tr_read<v_rd_off(0, 3, 0)>(vb), b3 = tr_read<v_rd_off(0, 3, 1)>(vb);
  const s16x4 c0 = tr_read<v_rd_off(1, 0, 0)>(vb), d0 = tr_read<v_rd_off(1, 0, 1)>(vb), c1 = tr_read<v_rd_off(1, 1, 0)>(vb), d1 = tr_read<v_rd_off(1, 1, 1)>(vb);
  const s16x4 c2 = tr_read<v_rd_off(1, 2, 0)>(vb), d2 = tr_read<v_rd_off(1, 2, 1)>(vb), c3 = tr_read<v_rd_off(1, 3, 0)>(vb), d3 = tr_read<v_rd_off(1, 3, 1)>(vb);
  asm volatile("s_waitcnt lgkmcnt(0)" ::: "memory"); SBAR();
#define PK(L, H) (bf16x8){L[0], L[1], L[2], L[3], H[0], H[1], H[2], H[3]}
  o[0] = __builtin_amdgcn_mfma_f32_32x32x16_bf16(pa0, PK(a0, b0), o[0], 0, 0, 0); o[1] = __builtin_amdgcn_mfma_f32_32x32x16_bf16(pa0, PK(c0, d0), o[1], 0, 0, 0);
  o[0] = __builtin_amdgcn_mfma_f32_32x32x16_bf16(pa1, PK(a1, b1), o[0], 0, 0, 0); o[1] = __builtin_amdgcn_mfma_f32_32x32x16_bf16(pa1, PK(c1, d1), o[1], 0, 0, 0);
  o[0] = __builtin_amdgcn_mfma_f32_32x32x16_bf16(pa2, PK(a2, b2), o[0], 0, 0, 0); o[1] = __builtin_amdgcn_mfma_f32_32x32x16_bf16(pa2, PK(c2, d2), o[1], 0, 0, 0);
  o[0] = __builtin_amdgcn_mfma_f32_32x32x16_bf16(pa3, PK(a3, b3), o[0], 0, 0, 0); o[1] = __builtin_amdgcn_mfma_f32_32x32x16_bf16(pa3, PK(c3, d3), o[1], 0, 0, 0);
#undef PK
}
#define ATT_RESC(a) do { if (__any((a) < 1.f)) { if (hi == 0) al_l[r32] = (a); asm volatile("s_waitcnt lgkmcnt(0)" ::: "memory"); \
    _Pragma("unroll") for (int d = 0; d < 2; ++d) _Pragma("unroll") for (int r = 0; r < 16; ++r) o[d][r] *= al_l[crow(r, hi)]; } } while (0)

constexpr int M2_K = 0, M2_V = 4 * SHM_K, M2_WS = M2_V + 4 * SHM_V, M2_END = M2_WS + 8 * 256;
__device__ __forceinline__ void glds16(unsigned voff, const void* sbase, unsigned lds_dst) { unsigned keep;
  asm volatile("s_mov_b32 %0, m0\n\ts_mov_b32 m0, %3\n\ts_nop 0\n\tglobal_load_lds_dwordx4 %1, %2\n\ts_mov_b32 m0, %0" : "=&s"(keep) : "v"(voff), "s"(sbase), "s"(lds_dst) : "memory"); }
#define MLA_WAIT_BAR() asm volatile("s_waitcnt vmcnt(0) lgkmcnt(0)\n\ts_barrier" ::: "memory")
__device__ __forceinline__ void packP(const f32x16& p0, const f32x16& p1, float alpha, float& l_reg, bf16x8& pa0, bf16x8& pa1, bf16x8& pa2, bf16x8& pa3) {
  float s0 = p0[0], s1 = p0[8], s2 = p1[0], s3 = p1[8];
#pragma unroll
  for (int r = 1; r < 8; ++r) { s0 += p0[r]; s1 += p0[8 + r]; s2 += p1[r]; s3 += p1[8 + r]; }
  float ps = (s0 + s1) + (s2 + s3);
  { auto rr = __builtin_amdgcn_permlane32_swap(__float_as_uint(ps), __float_as_uint(ps), false, false);
    ps = __uint_as_float(rr[0]) + __uint_as_float(rr[1]); }
  l_reg = l_reg * alpha + ps;
#define PK4N(P, BASE, OUT) do { u32x4 w = {cvt_pk_bf16(P[BASE + 0], P[BASE + 1]), cvt_pk_bf16(P[BASE + 2], P[BASE + 3]), cvt_pk_bf16(P[BASE + 4], P[BASE + 5]), cvt_pk_bf16(P[BASE + 6], P[BASE + 7])}; OUT = __builtin_bit_cast(bf16x8, w); } while (0)
  PK4N(p0, 0, pa0); PK4N(p0, 8, pa1); PK4N(p1, 0, pa2); PK4N(p1, 8, pa3);
#undef PK4N
}
__device__ __forceinline__ void finishSM2(f32x16& p0, f32x16& p1, float alpha, float& l_reg, bf16x8& pa0, bf16x8& pa1, bf16x8& pa2, bf16x8& pa3) {
#pragma unroll
  for (int r = 0; r < 16; ++r) p1[r] = __builtin_amdgcn_exp2f(p1[r]);
  packP(p0, p1, alpha, l_reg, pa0, pa1, pa2, pa3);
}
__device__ __forceinline__ void partialSM2(f32x16& p0, f32x16& p1, float& m_reg, f32x16& negm, float& alpha, const float THRL) {
  float ma = fmaxf(fmaxf(p0[0], p0[1]), p0[2]), mb = fmaxf(fmaxf(p1[0], p1[1]), p1[2]);
#pragma unroll
  for (int r = 3; r < 15; r += 2) { ma = fmaxf(fmaxf(ma, p0[r]), p0[r + 1]); mb = fmaxf(fmaxf(mb, p1[r]), p1[r + 1]); }
  float pmax = fmaxf(fmaxf(ma, p0[15]), fmaxf(mb, p1[15]));
  if (__builtin_expect(__all(pmax <= THRL), 1)) { alpha = 1.f; }
  else { { auto rr = __builtin_amdgcn_permlane32_swap(__float_as_uint(pmax), __float_as_uint(pmax), false, false);
           pmax = fmaxf(__uint_as_float(rr[0]), __uint_as_float(rr[1])); }
    const float dl = fmaxf(pmax, 0.f); m_reg += dl; alpha = __builtin_amdgcn_exp2f(-dl);
#pragma unroll
    for (int r = 0; r < 16; ++r) { p0[r] -= dl; p1[r] -= dl; }
#pragma unroll
    for (int r = 0; r < 16; ++r) negm[r] = -m_reg;
    asm volatile("" : "+v"(negm)); }
#pragma unroll
  for (int r = 0; r < 16; ++r) p0[r] = __builtin_amdgcn_exp2f(p0[r]);
}
template <int NKS> __device__ __forceinline__ void qkt_m(f32x16& p0, f32x16& p1, const LAS char* Ks, const bf16x8* qr, const f32x16& negm, int r32, int hi) {
  bf16x8 kf[2 * NKS];
#pragma unroll
  for (int d0 = 0; d0 < NKS; ++d0) { const int cb = (d0 * 16 + hi * 8) * 2;
    kf[2 * d0] = *(const LAS bf16x8*)(Ks + KSWZ(r32, cb)); kf[2 * d0 + 1] = *(const LAS bf16x8*)(Ks + KSWZ(32 + r32, cb)); }
  SBAR();
#pragma unroll
  for (int d0 = 0; d0 < NKS; ++d0) {
    if (d0 == 0) { p0 = __builtin_amdgcn_mfma_f32_32x32x16_bf16(kf[0], qr[0], negm, 0, 0, 0); p1 = __builtin_amdgcn_mfma_f32_32x32x16_bf16(kf[1], qr[0], negm, 0, 0, 0); }
    else { p0 = __builtin_amdgcn_mfma_f32_32x32x16_bf16(kf[2 * d0], qr[d0], p0, 0, 0, 0); p1 = __builtin_amdgcn_mfma_f32_32x32x16_bf16(kf[2 * d0 + 1], qr[d0], p1, 0, 0, 0); } }
}
template <int OFF> __device__ __forceinline__ bf16x8 lds_rd128(int a) { bf16x8 r; asm volatile("ds_read_b128 %0, %1 offset:%2" : "=&v"(r) : "v"(a), "i"(OFF) : "memory"); return r; }
__device__ __forceinline__ void mla_mseg(f32x16& p0, f32x16& p1, f32x16* o, int kb, int vb, const bf16x8* qr, const f32x16& negm, bf16x8 pa0, bf16x8 pa1, bf16x8 pa2, bf16x8 pa3, int r32, int hi) {
  bf16x8 kf[12];
#pragma unroll
  for (int d = 0; d < 6; ++d) { const int a = kb + KSWZ(r32, (d * 16 + hi * 8) * 2); kf[2 * d] = lds_rd128<0>(a); kf[2 * d + 1] = lds_rd128<8192>(a); }
#define KW(N, A, B) asm volatile("s_waitcnt lgkmcnt(" #N ")" : "+v"(A), "+v"(B) :: "memory")
  KW(10, kf[0], kf[1]); p0 = __builtin_amdgcn_mfma_f32_32x32x16_bf16(kf[0], qr[0], negm, 0, 0, 0); p1 = __builtin_amdgcn_mfma_f32_32x32x16_bf16(kf[1], qr[0], negm, 0, 0, 0);
  SBAR(); KW(8, kf[2], kf[3]); p0 = __builtin_amdgcn_mfma_f32_32x32x16_bf16(kf[2], qr[1], p0, 0, 0, 0); p1 = __builtin_amdgcn_mfma_f32_32x32x16_bf16(kf[3], qr[1], p1, 0, 0, 0);
  SBAR(); KW(6, kf[4], kf[5]); p0 = __builtin_amdgcn_mfma_f32_32x32x16_bf16(kf[4], qr[2], p0, 0, 0, 0); p1 = __builtin_amdgcn_mfma_f32_32x32x16_bf16(kf[5], qr[2], p1, 0, 0, 0);
  SBAR(); KW(4, kf[6], kf[7]); p0 = __builtin_amdgcn_mfma_f32_32x32x16_bf16(kf[6], qr[3], p0, 0, 0, 0); p1 = __builtin_amdgcn_mfma_f32_32x32x16_bf16(kf[7], qr[3], p1, 0, 0, 0);
#undef KW
  SBAR();
  const s16x4 a0 = tr_read<v_rd_off(0, 0, 0)>(vb), b0 = tr_read<v_rd_off(0, 0, 1)>(vb), c0 = tr_read<v_rd_off(1, 0, 0)>(vb), d0 = tr_read<v_rd_off(1, 0, 1)>(vb);
  const s16x4 a1 = tr_read<v_rd_off(0, 1, 0)>(vb), b1 = tr_read<v_rd_off(0, 1, 1)>(vb), c1 = tr_read<v_rd_off(1, 1, 0)>(vb), d1 = tr_read<v_rd_off(1, 1, 1)>(vb);
  const s16x4 a2 = tr_read<v_rd_off(0, 2, 0)>(vb), b2 = tr_read<v_rd_off(0, 2, 1)>(vb), c2 = tr_read<v_rd_off(1, 2, 0)>(vb), d2 = tr_read<v_rd_off(1, 2, 1)>(vb);
  const s16x4 a3 = tr_read<v_rd_off(0, 3, 0)>(vb), b3 = tr_read<v_rd_off(0, 3, 1)>(vb), c3 = tr_read<v_rd_off(1, 3, 0)>(vb), d3 = tr_read<v_rd_off(1, 3, 1)>(vb);
  asm volatile("s_waitcnt lgkmcnt(15)" : "+v"(kf[8]), "+v"(kf[9]), "+v"(kf[10]), "+v"(kf[11]) :: "memory");
  p0 = __builtin_amdgcn_mfma_f32_32x32x16_bf16(kf[8], qr[4], p0, 0, 0, 0); p1 = __builtin_amdgcn_mfma_f32_32x32x16_bf16(kf[9], qr[4], p1, 0, 0, 0);
  p0 = __builtin_amdgcn_mfma_f32_32x32x16_bf16(kf[10], qr[5], p0, 0, 0, 0); p1 = __builtin_amdgcn_mfma_f32_32x32x16_bf16(kf[11], qr[5], p1, 0, 0, 0);
  SBAR(); asm volatile("s_waitcnt lgkmcnt(0)" ::: "memory"); SBAR();
#define PK(L, H) (bf16x8){L[0], L[1], L[2], L[3], H[0], H[1], H[2], H[3]}
  o[0] = __builtin_amdgcn_mfma_f32_32x32x16_bf16(pa0, PK(a0, b0), o[0], 0, 0, 0); o[1] = __builtin_amdgcn_mfma_f32_32x32x16_bf16(pa0, PK(c0, d0), o[1], 0, 0, 0);
  o[0] = __builtin_amdgcn_mfma_f32_32x32x16_bf16(pa1, PK(a1, b1), o[0], 0, 0, 0); o[1] = __builtin_amdgcn_mfma_f32_32x32x16_bf16(pa1, PK(c1, d1), o[1], 0, 0, 0);
  o[0] = __builtin_amdgcn_mfma_f32_32x32x16_bf16(pa2, PK(a2, b2), o[0], 0, 0, 0); o[1] = __builtin_amdgcn_mfma_f32_32x32x16_bf16(pa2, PK(c2, d2), o[1], 0, 0, 0);
  o[0] = __builtin_amdgcn_mfma_f32_32x32x16_bf16(pa3, PK(a3, b3), o[0], 0, 0, 0); o[1] = __builtin_amdgcn_mfma_f32_32x32x16_bf16(pa3, PK(c3, d3), o[1], 0, 0, 0);
#undef PK
}
__device__ __forceinline__ void mla_unit(int b, int h, int qb, int kh, const bf16_t* __restrict__ QB, const bf16_t* __restrict__ KVB, const bf16_t* __restrict__ KR, bf16_t* __restrict__ OA, f32x2* __restrict__ ML, LAS char* lds) {
  int tid = threadIdx.x; asm volatile("" : "+v"(tid));
  const int wid = __builtin_amdgcn_readfirstlane(tid >> 6), lane = tid & 63, r32 = lane & 31, hi = lane >> 5;
  LAS char* K_lds = lds + M2_K;
  LAS float* wsf = (LAS float*)(lds + M2_WS) + wid * 64; LAS float* li_l = wsf; LAS float* al_l = wsf + 32;
  constexpr float SCALE = 0.10206207261596575f, C = SCALE * 1.4426950408889634f, THRL = 8.0f * 1.4426950408889634f;
  const long rowbase = (long)b * SEQ; const int qpos = qb * 256 + wid * 32 + r32;
  const long keybase = rowbase + (long)kh * (SEQ / 2);
  const char* const sbase = (const char*)KVB < (const char*)KR ? (const char*)KVB : (const char*)KR;
  const unsigned okv = (unsigned)((const char*)KVB - sbase), okr = (unsigned)((const char*)KR - sbase);
  unsigned ksrc[2], kstr[2];
#pragma unroll
  for (int i = 0; i < 2; ++i) { const int p = wid * 2 + i, row = 4 * p + (lane >> 4), c = (lane & 15) ^ (row & 15);
    if (c < 8) { ksrc[i] = okv + (unsigned)(((keybase + row) * 768 + h * 128 + c * 8) * 2); kstr[i] = 64u * 768u * 2u; }
    else { const int rc = c - 8; ksrc[i] = okr + (unsigned)(((keybase + row) * 32 + ((rc < 4 ? rc : 0) * 8)) * 2); kstr[i] = 64u * 32u * 2u; } }
  unsigned vsrc = okv + (unsigned)(((keybase + 8 * wid + ((lane & 31) >> 2)) * 768 + h * 128 + 64 + (lane >> 5) * 32 + (lane & 3) * 8) * 2);
  const unsigned lds0 = (unsigned)(size_t)lds;
  const unsigned kdst = lds0 + M2_K + wid * 2048, vdst = lds0 + M2_V + wid * 1024;
#define MLA_DMA(slot) do { glds16(ksrc[0], sbase, (unsigned)__builtin_amdgcn_readfirstlane(kdst + (slot) * SHM_K)); glds16(ksrc[1], sbase, (unsigned)__builtin_amdgcn_readfirstlane(kdst + (slot) * SHM_K + 1024)); \
    glds16(vsrc, sbase, (unsigned)__builtin_amdgcn_readfirstlane(vdst + (slot) * SHM_V)); ksrc[0] += kstr[0]; ksrc[1] += kstr[1]; vsrc += 64u * 768u * 2u; } while (0)
  MLA_DMA(0);
  float m_reg = 0.f, l_reg = 0.f; f32x16 o[2] = {}; bf16x8 qr[6];
  { const bf16_t* Qw = QB + (rowbase + qpos) * 768 + h * 96 + hi * 8;
#pragma unroll
    for (int d0 = 0; d0 < 6; ++d0) qr[d0] = *(const bf16x8*)(Qw + d0 * 16);
#pragma unroll
    for (int d0 = 0; d0 < 4; ++d0) { u32x4 x = __builtin_bit_cast(u32x4, qr[d0]);
#pragma unroll
      for (int i = 0; i < 4; ++i) x[i] = cvt_pk_bf16(bflo(x[i]) * C, bfhi(x[i]) * C);
      qr[d0] = __builtin_bit_cast(bf16x8, x); }
    u32x4 x1 = __builtin_bit_cast(u32x4, qr[4]), x2 = __builtin_bit_cast(u32x4, qr[5]); u32x4 y1, y2;
#pragma unroll
    for (int i = 0; i < 4; ++i) { float c0, s0, c1, s1; rope_cs(qpos, hi * 8 + 2 * i, c0, s0); rope_cs(qpos, hi * 8 + 2 * i + 1, c1, s1);
      const float a0 = bflo(x1[i]) * C, a1 = bfhi(x1[i]) * C, b0 = bflo(x2[i]) * C, b1 = bfhi(x2[i]) * C;
      y1[i] = cvt_pk_bf16(a0 * c0 - b0 * s0, a1 * c1 - b1 * s1); y2[i] = cvt_pk_bf16(a0 * s0 + b0 * c0, a1 * s1 + b1 * c1); }
    qr[4] = __builtin_bit_cast(bf16x8, y1); qr[5] = __builtin_bit_cast(bf16x8, y2); }
  const int vb0 = (int)lds0 + M2_V + v_rd_base(lane);
  f32x16 p0, p1; float al = 1.f; bf16x8 pa0, pa1, pa2, pa3; constexpr int NT = SEQ / 128;
  f32x16 negm = f32x16{}; asm volatile("" : "+v"(negm)); m_reg = 0.f;
  const int grp = wid >> 2;
#define MLA_BAR_L() asm volatile("s_waitcnt lgkmcnt(0)\n\ts_barrier" ::: "memory")
#define MLA_BAR_V3() asm volatile("s_waitcnt vmcnt(3) lgkmcnt(0)\n\ts_barrier" ::: "memory")
#define MLA_SOFTMAX() do { SBAR(); partialSM2(p0, p1, m_reg, negm, al, THRL); finishSM2(p0, p1, al, l_reg, pa0, pa1, pa2, pa3); ATT_RESC(al); SBAR(); } while (0)
#define MLA_MSEG(sk_, sv_) do { SBAR(); __builtin_amdgcn_s_setprio(2); mla_mseg(p0, p1, o, (int)lds0 + M2_K + (sk_) * SHM_K, vb0 + (sv_) * SHM_V, qr, negm, pa0, pa1, pa2, pa3, r32, hi); __builtin_amdgcn_s_setprio(0); SBAR(); } while (0)
  MLA_DMA(1);
  MLA_WAIT_BAR();
  if (grp == 0) {
    SBAR(); qkt_m<6>(p0, p1, K_lds, qr, negm, r32, hi); SBAR();
    MLA_BAR_L();
    if (2 < NT) MLA_DMA(2);
    MLA_SOFTMAX();
    MLA_BAR_V3();
#pragma unroll 1
    for (int j = 1; j < NT; ++j) {
      MLA_MSEG(j & 3, (j - 1) & 3);
      MLA_BAR_L();
      if (j + 2 < NT) MLA_DMA((j + 2) & 3);
      MLA_SOFTMAX();
      if (j + 2 < NT) MLA_BAR_V3(); else MLA_WAIT_BAR();
    }
    SBAR(); pv2b(o, vb0 + ((NT - 1) & 3) * SHM_V, pa0, pa1, pa2, pa3); SBAR();
    MLA_BAR_L();
    MLA_WAIT_BAR();
  } else {
    if (2 < NT) MLA_DMA(2);
    MLA_BAR_L();
    SBAR(); qkt_m<6>(p0, p1, K_lds, qr, negm, r32, hi); SBAR();
    MLA_BAR_V3();
#pragma unroll 1
    for (int j = 1; j < NT; ++j) {
      if (j + 2 < NT) MLA_DMA((j + 2) & 3);
      MLA_SOFTMAX();
      MLA_BAR_L();
      MLA_MSEG(j & 3, (j - 1) & 3);
      if (j + 2 < NT) MLA_BAR_V3(); else MLA_WAIT_BAR();
    }
    MLA_SOFTMAX();
    MLA_BAR_L();
    SBAR(); pv2b(o, vb0 + ((NT - 1) & 3) * SHM_V, pa0, pa1, pa2, pa3); SBAR();
    MLA_WAIT_BAR();
  }
#undef MLA_BAR_L
#undef MLA_BAR_V3
#undef MLA_SOFTMAX
#undef MLA_MSEG
#undef MLA_DMA
  if (hi == 0) li_l[r32] = l_reg;
  asm volatile("s_waitcnt lgkmcnt(0)" ::: "memory");
  if (hi == 0) ML[((size_t)(3 + kh) * MTOK + rowbase + qpos) * 8 + h] = (f32x2){0.6931471805599453f * m_reg, l_reg};
  bf16_t* Ow = OA + ((size_t)(3 + kh) * MTOK + rowbase + qb * 256 + wid * 32) * 384 + h * 64 + r32;
#pragma unroll
  for (int r = 0; r < 16; ++r) { const int orow = crow(r, hi); const float rl = __builtin_amdgcn_rcpf(li_l[orow]);
#pragma unroll
    for (int d0 = 0; d0 < 2; ++d0) Ow[(long)orow * 384 + d0 * 32] = (bf16_t)(cvt_pk_bf16(o[d0][r] * rl, 0.f) & 0xffffu); }
  asm volatile("s_waitcnt lgkmcnt(0)\n\ts_barrier" ::: "memory");
}

constexpr int WT_BYTES = 16384;
constexpr int W_RPB = 6 * WT_BYTES, W_WS = W_RPB + 2560, W_END = W_WS + 8 * 256;
#define KSWZ128(row, colB) ((row) * 128 + ((colB) ^ ((((row) >> 1) & 7) << 4)))
__device__ __forceinline__ void qkt128(f32x16& p0, f32x16& p1, const LAS char* Ks, const bf16x8* qr, int r32, int hi) {
  p0 = f32x16{}; p1 = f32x16{};
#pragma unroll
  for (int d0 = 0; d0 < 4; ++d0) { const int cb = (d0 * 16 + hi * 8) * 2;
    const bf16x8 b0 = *(const LAS bf16x8*)(Ks + KSWZ128(r32, cb));
    const bf16x8 b1 = *(const LAS bf16x8*)(Ks + KSWZ128(32 + r32, cb));
    p0 = __builtin_amdgcn_mfma_f32_32x32x16_bf16(b0, qr[d0], p0, 0, 0, 0);
    p1 = __builtin_amdgcn_mfma_f32_32x32x16_bf16(b1, qr[d0], p1, 0, 0, 0); }
}
#define WIN_SOFTMAX_PV(slot) do { float al_, mn_; bf16x8 pa0, pa1, pa2, pa3; partialSM(p0, p1, m_reg, mn_, al_, C, THRR); finishSM(p0, p1, al_, l_reg, pa0, pa1, pa2, pa3); \
    ATT_RESC(al_); pv2(o, vb0 + (slot) * WT_BYTES, pa0, pa1, pa2, pa3); } while (0)

__device__ __forceinline__ void dil_phase(int ua0, int na, const bf16_t* __restrict__ PROJ, bf16_t* __restrict__ OA, f32x2* __restrict__ ML, LAS char* lds) {
  int tid = threadIdx.x; asm volatile("" : "+v"(tid));
  const int wid = __builtin_amdgcn_readfirstlane(tid >> 6), lane = tid & 63, r32 = lane & 31, hi = lane >> 5;
  LAS float* wsf = (LAS float*)(lds + W_WS) + wid * 64; LAS float* li_l = wsf; LAS float* al_l = wsf + 32;
  constexpr float SCALE = 0.125f, C = SCALE * 1.4426950408889634f, THRR = 8.0f / SCALE;
  const int srow = tid >> 3, sc8 = tid & 7;
  const int kst = KSWZ128(srow, sc8 * 16), vst = 8192 + v_st(srow, sc8 * 8);
  const int vb0 = (int)(unsigned)(size_t)lds + 8192 + v_rd_base(lane);
  bf16x8 sk[6], sv[6], qn[4];
#define DIL_GEO(ua) const int bh_ = (ua) / 96, rem_ = (ua) % 96, g = rem_ >> 5, uu_ = rem_ & 31, h = bh_ % 6; const long rowbase = (long)(bh_ / 6) * SEQ; \
    const int d = (g == 0) ? 1 : ((g == 1) ? 4 : 16), n = SEQ / d, res = uu_ % d, i0 = (uu_ / d) * 256
#define DIL_LOAD(ua) do { DIL_GEO(ua); _Pragma("unroll") for (int t = 0; t < 6; ++t) { int ki = i0 - 64 + 64 * t + srow; ki = min(max(ki, 0), n - 1); \
      const bf16_t* p_ = PROJ + (rowbase + (long)ki * d + res) * PJ + h * 64 + sc8 * 8; sk[t] = *(const bf16x8*)(p_ + PC_KA); sv[t] = *(const bf16x8*)(p_ + PC_VA); } \
    const bf16_t* Qw = PROJ + (rowbase + (long)(i0 + wid * 32 + r32) * d + res) * PJ + PC_QA + h * 64 + hi * 8; \
    _Pragma("unroll") for (int d0 = 0; d0 < 4; ++d0) qn[d0] = *(const bf16x8*)(Qw + d0 * 16); } while (0)
  if (na > 0) DIL_LOAD(ua0);
#pragma unroll 1
  for (int k = 0; k < na; ++k) {
    DIL_GEO(ua0 + k);
#pragma unroll
    for (int t = 0; t < 6; ++t) { *(LAS bf16x8*)(lds + t * WT_BYTES + kst) = sk[t]; *(LAS bf16x8*)(lds + t * WT_BYTES + vst) = sv[t]; }
    bf16x8 qr[4];
#pragma unroll
    for (int d0 = 0; d0 < 4; ++d0) qr[d0] = qn[d0];
    __syncthreads();
    if (k + 1 < na) DIL_LOAD(ua0 + k + 1);
    const int qi = i0 + wid * 32 + r32;
    const float slope = 8.0f * exp2f(-8.0f * (float)(h + 1) / 6.0f) * (float)d;
    float m_reg = -1e30f, l_reg = 0.f; f32x16 o[2] = {};
#pragma unroll 1
    for (int tt = 0; tt < 3; ++tt) {
      const int t = (wid >> 1) + tt;
      const int tstart = i0 - 64 + 64 * t;
      if (tstart < 0 || tstart >= n) continue;
      f32x16 p0, p1;
      qkt128(p0, p1, lds + t * WT_BYTES, qr, r32, hi);
      const float kbf = (float)(tstart - qi + 4 * hi);
#pragma unroll
      for (int r = 0; r < 16; ++r) { const float dl0 = kbf + (float)((r & 3) + 8 * (r >> 2)), dl1 = dl0 + 32.0f;
        p0[r] = (fabsf(dl0) <= 64.0f) ? fmaf(-slope, fabsf(dl0), p0[r]) : -1e30f; p1[r] = (fabsf(dl1) <= 64.0f) ? fmaf(-slope, fabsf(dl1), p1[r]) : -1e30f; }
      WIN_SOFTMAX_PV(t);
    }
    if (hi == 0) li_l[r32] = l_reg;
    asm volatile("s_waitcnt lgkmcnt(0)" ::: "memory");
    if (hi == 0) ML[((size_t)g * MTOK + rowbase + (long)qi * d + res) * 8 + h] = (f32x2){SCALE * m_reg, l_reg};
#pragma unroll
    for (int r = 0; r < 16; ++r) { const int orow = crow(r, hi); const float rl = __builtin_amdgcn_rcpf(li_l[orow]);
      bf16_t* Ow = OA + ((size_t)g * MTOK + rowbase + (long)(i0 + wid * 32 + orow) * d + res) * 384 + h * 64 + r32;
#pragma unroll
      for (int d0 = 0; d0 < 2; ++d0) Ow[d0 * 32] = (bf16_t)(cvt_pk_bf16(o[d0][r] * rl, 0.f) & 0xffffu); }
    __syncthreads();
  }
#undef DIL_GEO
#undef DIL_LOAD
}

__device__ __forceinline__ void nat_phase(int uc0, int nc, const bf16_t* __restrict__ PROJ, bf16_t* __restrict__ YC, const float* __restrict__ rpb_l, LAS char* lds) {
  int tid = threadIdx.x; asm volatile("" : "+v"(tid));
  const int wid = __builtin_amdgcn_readfirstlane(tid >> 6), lane = tid & 63, r32 = lane & 31, hi = lane >> 5;
  LAS float* wsf = (LAS float*)(lds + W_WS) + wid * 64; LAS float* li_l = wsf; LAS float* al_l = wsf + 32; LAS float* rpbL = (LAS float*)(lds + W_RPB + 256);
  constexpr float SCALE = 0.125f, C = SCALE * 1.4426950408889634f, THRR = 8.0f / SCALE;
  const int srow = tid >> 3, sc8 = tid & 7;
  const int kst = KSWZ128(srow, sc8 * 16), vst = 8192 + v_st(srow, sc8 * 8);
  const int vb0 = (int)(unsigned)(size_t)lds + 8192 + v_rd_base(lane);
  bf16x8 sk[6], sv[6], qn[4];
#define NAT_GEO(uc) const int bh_ = (uc) >> 5, uu = (uc) & 31, h = bh_ & 3; const long rowbase = (long)(bh_ >> 2) * SEQ; const bool edge = (uu == 0 || uu == 31); const int R0 = min(max(4 * uu - 4, 0), 120)
#define NAT_RL(s, t) (edge ? ((s) * 6 + (t)) : ((s) == 0 ? ((t) < 3 ? (t) : (t) + 5) : (t) + 3))
#define NAT_NT(s) (edge ? ((s) == 0 ? 6 : 2) : ((s) == 0 ? 6 : 5))
#define NAT_LOAD(uc, s) do { NAT_GEO(uc); _Pragma("unroll") for (int t = 0; t < 6; ++t) { const int rl_ = min(NAT_RL(s, t), edge ? 7 : 10); \
      const bf16_t* p_ = PROJ + (rowbase + (long)(R0 + rl_) * 64 + srow) * PJ + h * 64 + sc8 * 8; sk[t] = *(const bf16x8*)(p_ + PC_KC); sv[t] = *(const bf16x8*)(p_ + PC_VC); } \
    if ((s) == 0) { const bf16_t* Qw = PROJ + (rowbase + 256 * uu + 32 * wid + r32) * PJ + PC_QC + h * 64 + hi * 8; \
      _Pragma("unroll") for (int d0 = 0; d0 < 4; ++d0) qn[d0] = *(const bf16x8*)(Qw + d0 * 16); } } while (0)
  if (nc > 0) NAT_LOAD(uc0, 0);
  float m_reg = -1e30f, l_reg = 0.f; f32x16 o[2] = {}; bf16x8 qr[4] = {};
#pragma unroll 1
  for (int st = 0; st < 2 * nc; ++st) {
    const int s = st & 1; NAT_GEO(uc0 + (st >> 1));
#pragma unroll
    for (int t = 0; t < 6; ++t) { *(LAS bf16x8*)(lds + t * WT_BYTES + kst) = sk[t]; *(LAS bf16x8*)(lds + t * WT_BYTES + vst) = sv[t]; }
    if (s == 0) {
#pragma unroll
      for (int d0 = 0; d0 < 4; ++d0) qr[d0] = qn[d0];
      for (int t = tid; t < 15 * 31; t += 512) rpbL[t] = rpb_l[h * 465 + t] * 8.0f;
      m_reg = -1e30f; l_reg = 0.f; o[0] = f32x16{}; o[1] = f32x16{};
    }
    __syncthreads();
    if (st + 1 < 2 * nc) { if (s == 0) NAT_LOAD(uc0 + (st >> 1), 1); else NAT_LOAD(uc0 + (st >> 1) + 1, 0); }
    const int rq = 4 * uu + (wid >> 1), cq = 32 * (wid & 1) + r32, rs = min(max(rq - 4, 0), 120), cs = min(max(cq - 8, 0), 48);
    const int ntl = NAT_NT(s);
#pragma unroll 1
    for (int t = 0; t < ntl; ++t) {
      const int kr = R0 + NAT_RL(s, t);
      if (kr >= rs && kr < rs + 8) {
        f32x16 p0, p1;
        qkt128(p0, p1, lds + t * WT_BYTES, qr, r32, hi);
        const LAS float* bp = rpbL + ((kr - rq + 7) * 31 + 15 - cq + 4 * hi);
        const unsigned t0 = (unsigned)(4 * hi - cs);
#pragma unroll
        for (int r = 0; r < 16; ++r) { const int c0 = (r & 3) + 8 * (r >> 2);
          p0[r] = (t0 + (unsigned)c0 < 16u) ? p0[r] + bp[c0] : -1e30f; p1[r] = (t0 + (unsigned)(c0 + 32) < 16u) ? p1[r] + bp[c0 + 32] : -1e30f; }
        WIN_SOFTMAX_PV(t);
      }
    }
    if (s == 1) {
      if (hi == 0) li_l[r32] = l_reg;
      asm volatile("s_waitcnt lgkmcnt(0)" ::: "memory");
#pragma unroll
      for (int r = 0; r < 16; ++r) { const int orow = crow(r, hi); const float rl = __builtin_amdgcn_rcpf(li_l[orow]);
        bf16_t* Ow = YC + (rowbase + 256 * uu + 32 * wid + orow) * 256 + h * 64 + r32;
#pragma unroll
        for (int d0 = 0; d0 < 2; ++d0) Ow[d0 * 32] = (bf16_t)(cvt_pk_bf16(o[d0][r] * rl, 0.f) & 0xffffu); }
    }
    __syncthreads();
  }
#undef NAT_GEO
#undef NAT_RL
#undef NAT_NT
#undef NAT_LOAD
}
#undef WIN_SOFTMAX_PV
#undef ATT_RESC
}

#define RLX_AGENT __ATOMIC_RELAXED, __HIP_MEMORY_SCOPE_AGENT
#define XB_TMO      128
#define XB_XCNT(j)  (256  + 64 * (j))
#define XB_XSUB(j)  (1280 + 64 * (j))
#define XB_XGEN(j)  (2304 + 64 * (j))
#define XB_TOP      3328
#define XB_TOPGEN   3392
#define XCD_BAR_WORDS 3456
#define XB_SPIN_CAP (1u << 18)
__device__ __forceinline__ unsigned xb_ld(unsigned* p)              { return __hip_atomic_load(p, __ATOMIC_RELAXED, __HIP_MEMORY_SCOPE_AGENT); }
__device__ __forceinline__ unsigned xb_add(unsigned* p, unsigned v) { return __hip_atomic_fetch_add(p, v, __ATOMIC_RELAXED, __HIP_MEMORY_SCOPE_AGENT); }
__device__ __forceinline__ unsigned xb_xcc_id() { return (unsigned)__builtin_amdgcn_s_getreg((3 << 11) | 20) & 0xFu; }
#define XB_SPIN(cond, bar) do { unsigned _sp = 0; while (cond) { __builtin_amdgcn_s_sleep(1); \
    if ((++_sp & 255u) == 0u) { if (xb_ld(&(bar)[XB_TMO])) break; if (_sp > XB_SPIN_CAP) { atomicAdd(&(bar)[XB_TMO], 1u); break; } } } } while (0)
struct XcdBarrier { unsigned* bar; unsigned x; volatile LAS unsigned* st; };
__device__ __forceinline__ XcdBarrier xcd_barrier_post(unsigned* bar, volatile LAS unsigned* st) {
    XcdBarrier b; b.bar = bar; b.x = xb_xcc_id(); b.st = st;
    if (threadIdx.x == 0) (void)xb_add(&bar[XB_XCNT(b.x)], 1u);
    return b;
}
__device__ __forceinline__ void xcd_barrier_complete(unsigned* bar, unsigned x, unsigned& nloc, unsigned& nx) {
    const unsigned G = gridDim.x * gridDim.y * gridDim.z;
    unsigned sum, cnt, mine, sp = 0u;
    for (;;) {
        sum = 0u; cnt = 0u; mine = 0u;
#pragma unroll
        for (unsigned j = 0; j < 16; ++j) { const unsigned c = xb_ld(&bar[XB_XCNT(j)]); sum += c; cnt += (c > 0u) ? 1u : 0u; mine = (j == x) ? c : mine; }
        if (sum == G) break;
        __builtin_amdgcn_s_sleep(1);
        if ((++sp & 255u) == 0u) { if (xb_ld(&bar[XB_TMO])) break; if (sp > XB_SPIN_CAP) { atomicAdd(&bar[XB_TMO], 1u); break; } }
    }
    nloc = mine > 0u ? mine : 1u; nx = cnt > 0u ? cnt : 1u;
}
__device__ __forceinline__ void xcd_barrier(const XcdBarrier& b) {
    asm volatile("s_waitcnt vmcnt(0)" ::: "memory");
    __syncthreads();
    if (threadIdx.x == 0) {
        unsigned* bar = b.bar;
        __builtin_amdgcn_s_waitcnt(0);
        unsigned nloc = b.st[0], nx = b.st[1];
        if (nloc == 0u) { xcd_barrier_complete(bar, b.x, nloc, nx); b.st[0] = nloc; b.st[1] = nx; }
        const unsigned old = xb_add(&bar[XB_XSUB(b.x)], 1u);
        const unsigned gen = old / nloc;
        if (old + 1u == (gen + 1u) * nloc) {
            __builtin_amdgcn_fence(__ATOMIC_RELEASE, "agent");
            asm volatile("s_waitcnt vmcnt(0)" ::: "memory");
            const unsigned og = xb_add(&bar[XB_TOP], 1u);
            const unsigned tg = og / nx;
            if (og + 1u == (tg + 1u) * nx) xb_add(&bar[XB_TOPGEN], 1u);
            else XB_SPIN(xb_ld(&bar[XB_TOPGEN]) == tg, bar);
            __builtin_amdgcn_fence(__ATOMIC_ACQUIRE, "agent");
            xb_add(&bar[XB_XGEN(b.x)], 1u);
            asm volatile("s_waitcnt vmcnt(0)" ::: "memory");
        } else {
            XB_SPIN(xb_ld(&bar[XB_XGEN(b.x)]) == gen, bar);
            __builtin_amdgcn_fence(__ATOMIC_ACQUIRE, "agent");
            asm volatile("s_waitcnt vmcnt(0)" ::: "memory");
        }
    }
    __syncthreads();
}

constexpr int RING_OFF = 0, RING_BYTES = 131072;
constexpr int MISC_OFF = RING_BYTES;
constexpr int LDS_BYTES = 147456;
static_assert(att::L_END <= RING_BYTES && att::W_END <= RING_BYTES && att::M2_END <= RING_BYTES, "attention scratch inside the ring region");

template <class RowMap>
__device__ __forceinline__ void tr_item(const float* __restrict__ W, int K, int N, bf16_t* __restrict__ WT, LAS float* scr, int item, int lane, RowMap rm) {
    const int nblk = N / 32, kb = item / nblk, nb = item % nblk, k0 = 64 * kb, n0 = 32 * nb;
#pragma unroll 8
    for (int i = 0; i < 32; ++i) { const int kk = 2 * i + (lane >> 5); scr[kk * 33 + (lane & 31)] = W[(size_t)(k0 + kk) * N + n0 + (lane & 31)]; }
    LDS_WAIT(); asm volatile("" ::: "memory");
    const int c = lane & 7;
#pragma unroll
    for (int j = 0; j < 4; ++j) { const int n = (lane >> 3) + 8 * j; const LAS float* s = scr + (8 * c) * 33 + n;
        u32x4 o; o.x = cvt_pk_bf16(s[0 * 33], s[1 * 33]); o.y = cvt_pk_bf16(s[2 * 33], s[3 * 33]); o.z = cvt_pk_bf16(s[4 * 33], s[5 * 33]); o.w = cvt_pk_bf16(s[6 * 33], s[7 * 33]);
        *(u32x4*)(WT + (size_t)rm(n0 + n) * K + k0 + 8 * c) = o; }
    LDS_WAIT(); asm volatile("" ::: "memory");
}
struct RmId  { __device__ __forceinline__ int operator()(int n) const { return n; } };
struct RmIn  { __device__ __forceinline__ int operator()(int n) const { return n < 1792 ? n : (n < 1824 ? n + 768 : n - 32); } };
struct RmW1  { __device__ __forceinline__ int operator()(int n) const { return 8 * (n >> 2) + (n & 3); } };
struct RmW3  { __device__ __forceinline__ int operator()(int n) const { return 8 * (n >> 2) + 4 + (n & 3); } };

typedef __attribute__((address_space(4))) const unsigned char* kptr_t;
constexpr int CV_ATT = 16 * 81 + 6 * 18 + 4 * 24 + 16 * 32, CV_FFN = 3 * 16 * 88, CV_MOE = 3 * 8 * 16 * 112;
constexpr int CV_A = CV_ATT + CV_FFN, CV_F1 = CV_A + CV_ATT, CV_F2 = CV_F1 + CV_MOE, CV_F3 = CV_F2 + CV_ATT + CV_FFN, CV_F4 = CV_F3 + CV_ATT, CV_F5 = CV_F4 + CV_MOE, CV_END = CV_F5;
static_assert(CV_ATT == 2012 && CV_FFN == 4224 && CV_MOE == 43008 && CV_END == 102512, "conversion item counts");
struct CvtItem { const float* src; bf16_t* dst; const float* gain; int K, N, kind, k0, n0; };
__device__ __forceinline__ int cvt_row(int kind, int n) { return kind == 0 ? n : (kind == 1 ? (n < 1792 ? n : (n < 1824 ? n + 768 : n - 32)) : 8 * (n >> 2) + (kind == 3 ? 4 : 0) + (n & 3)); }
__device__ __forceinline__ CvtItem cvt_decode(int idx, kptr_t kp, GAS unsigned char* ws) {
#define CV_IN(i) ((const float*)(*(GAS const float* const __attribute__((address_space(4)))*)(kp + 8 * (i))))
#define CV_WS(off) ((bf16_t*)(GAS bf16_t*)(ws + (off)))
    CvtItem t; t.gain = nullptr; int r, g, L, q;
    if (idx < CV_ATT) { g = 0; L = 0; q = idx; } else if (idx < CV_A) { g = 1; L = 0; q = idx - CV_ATT; } else if (idx < CV_F1) { g = 0; L = 1; q = idx - CV_A; }
    else if (idx < CV_F2) { g = 2; L = 0; q = idx - CV_F1; } else if (idx < CV_F2 + CV_ATT) { g = 0; L = 2; q = idx - CV_F2; } else if (idx < CV_F3) { g = 1; L = 1; q = idx - CV_F2 - CV_ATT; }
    else if (idx < CV_F4) { g = 0; L = 3; q = idx - CV_F3; } else { g = 2; L = 1; q = idx - CV_F4; }
    if (g == 0) {
        if (q < 1296) { r = q; t.src = CV_IN(2) + (size_t)L * DM * IN_COLS; t.K = DM; t.N = IN_COLS; t.dst = CV_WS(WS_WIN) + (size_t)L * PJ * DM; t.kind = 1; t.gain = CV_IN(1) + (size_t)L * DM; }
        else if (q < 1404) { r = q - 1296; t.src = CV_IN(5) + (size_t)L * QLR * QUP; t.K = QLR; t.N = QUP; t.dst = CV_WS(WS_WUQ) + (size_t)L * QUP_PAD * QLR; t.kind = 0; t.gain = CV_IN(3) + (size_t)L * QLR; }
        else if (q < 1500) { r = q - 1404; t.src = CV_IN(6) + (size_t)L * KVLR * KVUP; t.K = KVLR; t.N = KVUP; t.dst = CV_WS(WS_WUKV) + (size_t)L * KVUP * KVLR; t.kind = 0; t.gain = CV_IN(4) + (size_t)L * KVLR; }
        else { r = q - 1500; t.src = CV_IN(11) + (size_t)L * DM * DM; t.K = DM; t.N = DM; t.dst = CV_WS(WS_WO) + (size_t)L * DM * DM; t.kind = 0; }
    } else if (g == 1) {
        const int tt = q / 1408; r = q % 1408;
        if (tt < 2) { t.src = CV_IN(tt == 0 ? 13 : 14) + (size_t)L * DM * DFF; t.K = DM; t.N = DFF; t.dst = CV_WS(WS_W13) + (size_t)L * 2 * DFF * DM; t.kind = 2 + tt; t.gain = CV_IN(12) + (size_t)(2 * L) * DM; }
        else { t.src = CV_IN(15) + (size_t)L * DFF * DM; t.K = DFF; t.N = DM; t.dst = CV_WS(WS_W2) + (size_t)L * DM * DFF; t.kind = 0; }
    } else {
        const int tt = q / 14336, mi = L * 8 + (q % 14336) / 1792; r = q % 1792;
        if (tt < 2) { t.src = CV_IN(tt == 0 ? 17 : 18) + (size_t)mi * DM * DFFE; t.K = DM; t.N = DFFE; t.dst = CV_WS(WS_EW13) + (size_t)mi * 2 * DFFE * DM; t.kind = 2 + tt; }
        else { t.src = CV_IN(19) + (size_t)mi * DFFE * DM; t.K = DFFE; t.N = DM; t.dst = CV_WS(WS_EW2) + (size_t)mi * DM * DFFE; t.kind = 0; }
    }
    const int nblk = t.N / 32; t.k0 = 64 * (r / nblk); t.n0 = 32 * (r % nblk); return t;
#undef CV_IN
#undef CV_WS
}
__device__ __forceinline__ void cvt_load(const CvtItem& t, float (&v)[32], int lane) {
#pragma unroll
    for (int i = 0; i < 32; ++i) v[i] = t.src[(size_t)(t.k0 + 2 * i + (lane >> 5)) * t.N + t.n0 + (lane & 31)];
}
__device__ __forceinline__ void cvt_store(const CvtItem& t, const float (&v)[32], LAS float* scr, int lane) {
#pragma unroll
    for (int i = 0; i < 32; ++i) scr[(2 * i + (lane >> 5)) * 33 + (lane & 31)] = v[i];
    LDS_WAIT(); asm volatile("" ::: "memory");
    const int c = lane & 7;
    f32x4 g0 = {1.f, 1.f, 1.f, 1.f}, g1 = g0;
    if (t.gain) { g0 = *(const f32x4*)(t.gain + t.k0 + 8 * c); g1 = *(const f32x4*)(t.gain + t.k0 + 8 * c + 4); }
#pragma unroll
    for (int j = 0; j < 4; ++j) { const int n = (lane >> 3) + 8 * j; const LAS float* s = scr + (8 * c) * 33 + n;
        u32x4 o; o.x = cvt_pk_bf16(s[0 * 33] * g0.x, s[1 * 33] * g0.y); o.y = cvt_pk_bf16(s[2 * 33] * g0.z, s[3 * 33] * g0.w); o.z = cvt_pk_bf16(s[4 * 33] * g1.x, s[5 * 33] * g1.y); o.w = cvt_pk_bf16(s[6 * 33] * g1.z, s[7 * 33] * g1.w);
        *(u32x4*)(t.dst + (size_t)cvt_row(t.kind, t.n0 + n) * t.K + t.k0 + 8 * c) = o; }
    LDS_WAIT(); asm volatile("" ::: "memory");
}
__device__ __forceinline__ void p_prologue(kptr_t kp, GAS unsigned char* ws, LAS unsigned char* lds, int gw, int NGW, int wave, int lane, int gtid, int NGT) {
    asm volatile("" : "+v"(lane), "+v"(gtid));
    LAS float* scr = (LAS float*)(lds + RING_OFF + wave * 16384);
    for (int it = gw; it < CV_END; it += NGW) { const CvtItem t = cvt_decode(it, kp, ws); float v[32]; cvt_load(t, v, lane); cvt_store(t, v, scr, lane); }
    bf16_t* WIN = (bf16_t*)(GAS bf16_t*)(ws + WS_WIN); bf16_t* WUQ = (bf16_t*)(GAS bf16_t*)(ws + WS_WUQ);
    const u32x4 z = {0u, 0u, 0u, 0u};
    for (int i = gtid; i < 4 * (PJ - IN_COLS) * DM / 8; i += NGT) { const int l = i / ((PJ - IN_COLS) * DM / 8), r = i % ((PJ - IN_COLS) * DM / 8); *(u32x4*)(WIN + ((size_t)l * PJ + IN_COLS) * DM + (size_t)r * 8) = z; }
    for (int i = gtid; i < 4 * (QUP_PAD - QUP) * QLR / 8; i += NGT) { const int l = i / ((QUP_PAD - QUP) * QLR / 8), r = i % ((QUP_PAD - QUP) * QLR / 8); *(u32x4*)(WUQ + ((size_t)l * QUP_PAD + QUP) * QLR + (size_t)r * 8) = z; }
}
struct MoeRow { i32x4 asg; f32x2 gate; };
template <int R, bool B16>
__device__ __forceinline__ void load_rows(f32x4 (&v)[R][4], const void* src, const int (&m)[R], int lane, bool combine, const i32x4* ASG, const f32x2* GATE, const float* YB, const LAS int* sbm) {
#pragma unroll
    for (int r = 0; r < R; ++r) {
        if constexpr (B16) { const u32x2* xr = (const u32x2*)((const bf16_t*)src + (size_t)m[r] * DM) + lane;
#pragma unroll
            for (int j = 0; j < 4; ++j) { const u32x2 w = xr[64 * j]; v[r][j] = (f32x4){bflo(w.x), bfhi(w.x), bflo(w.y), bfhi(w.y)}; } }
        else { const f32x4* xr = (const f32x4*)((const float*)src + (size_t)m[r] * DM) + lane;
#pragma unroll
            for (int j = 0; j < 4; ++j) v[r][j] = xr[64 * j]; } }
    if (combine) {
        i32x4 a[R]; f32x2 g[R]; const int tailrows = sbm[16]  ; const bf16_t* YBb = (const bf16_t*)YB; const bf16_t* YP = YBb + (WS_YP - WS_YB) / 2;
#pragma unroll
        for (int r = 0; r < R; ++r) { a[r] = ASG[m[r]]; g[r] = GATE[m[r]]; }
        f32x4 y0[R][4], y1[R][4];
#pragma unroll
        for (int r = 0; r < R; ++r) { const size_t r0 = (size_t)sbm[a[r].x] * 256 + a[r].y, r1 = (size_t)sbm[a[r].z] * 256 + a[r].w;
            const u32x2* p0 = (const u32x2*)(YBb + r0 * DM) + lane; const u32x2* p1 = (const u32x2*)(YBb + r1 * DM) + lane;
#pragma unroll
            for (int j = 0; j < 4; ++j) { const u32x2 w0 = p0[64 * j], w1 = p1[64 * j]; y0[r][j] = (f32x4){bflo(w0.x), bfhi(w0.x), bflo(w0.y), bfhi(w0.y)}; y1[r][j] = (f32x4){bflo(w1.x), bfhi(w1.x), bflo(w1.y), bfhi(w1.y)}; }
            if (r0 < (size_t)tailrows) { for (int q = 0; q < 3; ++q) { const u32x2* pp = (const u32x2*)(YP + ((size_t)q * 2048 + r0) * DM) + lane;
#pragma unroll
                for (int j = 0; j < 4; ++j) { const u32x2 w = pp[64 * j]; y0[r][j] += (f32x4){bflo(w.x), bfhi(w.x), bflo(w.y), bfhi(w.y)}; } } }
            if (r1 < (size_t)tailrows) { for (int q = 0; q < 3; ++q) { const u32x2* pp = (const u32x2*)(YP + ((size_t)q * 2048 + r1) * DM) + lane;
#pragma unroll
                for (int j = 0; j < 4; ++j) { const u32x2 w = pp[64 * j]; y1[r][j] += (f32x4){bflo(w.x), bfhi(w.x), bflo(w.y), bfhi(w.y)}; } } } }
#pragma unroll
        for (int r = 0; r < R; ++r)
#pragma unroll
            for (int j = 0; j < 4; ++j) v[r][j] = (v[r][j] + g[r].x * y0[r][j]) + g[r].y * y1[r][j];
    }
}
__device__ __forceinline__ float row_ss(const f32x4 (&v)[4]) {
    float s = 0.f;
#pragma unroll
    for (int j = 0; j < 4; ++j) s += (v[j].x * v[j].x + v[j].y * v[j].y) + (v[j].z * v[j].z + v[j].w * v[j].w);
    return s;
}
__device__ __forceinline__ float row_rstd(const f32x4 (&v)[4]) { return 1.0f / sqrtf(wave_sum(row_ss(v)) * (1.0f / DM) + RMS_EPS); }
template <int R, bool B16>
__device__ __forceinline__ void t_norm(const void* src, bf16_t* xdst, float* RS, int gw, int NGW, int lane, bool combine, const i32x4* ASG, const f32x2* GATE, const float* YB, const LAS int* sbm) {
    asm volatile("" : "+v"(lane));
    for (int m0 = gw; m0 < MTOK; m0 += R * NGW) {
        int m[R]; f32x4 v[R][4];
#pragma unroll
        for (int r = 0; r < R; ++r) m[r] = min(m0 + r * NGW, MTOK - 1);
        load_rows<R, B16>(v, src, m, lane, combine, ASG, GATE, YB, sbm);
#pragma unroll
        for (int r = 0; r < R; ++r) {
            const float rstd = row_rstd(v[r]);
            if (m0 + r * NGW < MTOK) {
                if (xdst) { u32x2* xo = (u32x2*)(xdst + (size_t)m[r] * DM) + lane;
#pragma unroll
                    for (int j = 0; j < 4; ++j) { u32x2 w; w.x = cvt_pk_bf16(v[r][j].x, v[r][j].y); w.y = cvt_pk_bf16(v[r][j].z, v[r][j].w); xo[64 * j] = w; } }
                if (lane == 0) RS[m[r]] = rstd;
            }
        }
    }
}
__device__ __forceinline__ void t_rs(const float* SS, float* RS, int bx, int G, int tid) {
    for (int m = bx + G * tid; m < MTOK; m += G * 512) { const f32x4* p = (const f32x4*)(SS + (size_t)m * 16); const f32x4 a = p[0], b = p[1], c = p[2], d = p[3];
        const float sq = (((a.x + a.y) + (a.z + a.w)) + ((b.x + b.y) + (b.z + b.w))) + (((c.x + c.y) + (c.z + c.w)) + ((d.x + d.y) + (d.z + d.w)));
        RS[m] = 1.0f / sqrtf(sq * (1.0f / DM) + RMS_EPS); }
}
template <bool B16>
__device__ __forceinline__ void t_final(const void* src, float* out, const float* gain, int gw, int NGW, int lane, bool combine, const i32x4* ASG, const f32x2* GATE, const float* YB, const LAS int* sbm) {
    asm volatile("" : "+v"(lane));
    constexpr int R = 2;
    f32x4 gg[4];
#pragma unroll
    for (int j = 0; j < 4; ++j) gg[j] = *((const f32x4*)gain + lane + 64 * j);
    for (int m0 = gw; m0 < MTOK; m0 += R * NGW) {
        int m[R]; f32x4 v[R][4];
#pragma unroll
        for (int r = 0; r < R; ++r) m[r] = min(m0 + r * NGW, MTOK - 1);
        load_rows<R, B16>(v, src, m, lane, combine, ASG, GATE, YB, sbm);
#pragma unroll
        for (int r = 0; r < R; ++r) {
            const float rstd = row_rstd(v[r]);
            if (m0 + r * NGW < MTOK) { f32x4* xo = (f32x4*)(out + (size_t)m[r] * DM) + lane;
#pragma unroll
                for (int j = 0; j < 4; ++j) xo[64 * j] = v[r][j] * rstd * gg[j]; }
        }
    }
}
__device__ __forceinline__ void t_mla_prep(const bf16_t* PROJ, const float* gq, const float* gkv, bf16_t* CQN, bf16_t* CKVN, bf16_t* KR, int gw, int NGW, int lane) {
    asm volatile("" : "+v"(lane));
    constexpr int R = 8;
    f32x4 gq0 = {0.f, 0.f, 0.f, 0.f}, gq1 = gq0, gk0 = gq0, gk1 = gq0;
    if (lane < 48) { gq0 = *(const f32x4*)(gq + 8 * lane); gq1 = *(const f32x4*)(gq + 8 * lane + 4); }
    if (lane < 32) { gk0 = *(const f32x4*)(gkv + 8 * lane); gk1 = *(const f32x4*)(gkv + 8 * lane + 4); }
    for (int m0 = gw; m0 < MTOK; m0 += R * NGW) {
        u32x4 a[R], b[R]; unsigned short k1[R], k2[R]; int m[R];
#pragma unroll
        for (int r = 0; r < R; ++r) { m[r] = min(m0 + r * NGW, MTOK - 1); const bf16_t* p = PROJ + (size_t)m[r] * PJ;
            a[r] = (u32x4){0u, 0u, 0u, 0u}; b[r] = a[r]; k1[r] = 0; k2[r] = 0;
            if (lane < 48) a[r] = *(const u32x4*)(p + PC_CQ + 8 * lane);
            if (lane < 32) b[r] = *(const u32x4*)(p + PC_CKV + 8 * lane);
            if (lane < 16) { k1[r] = p[PC_KR + lane]; k2[r] = p[PC_KR + 16 + lane]; } }
#pragma unroll
        for (int r = 0; r < R; ++r) {
            float fa[8], fb[8]; float sa = 0.f, sb = 0.f;
#pragma unroll
            for (int i = 0; i < 4; ++i) { fa[2 * i] = bflo(a[r][i]); fa[2 * i + 1] = bfhi(a[r][i]); fb[2 * i] = bflo(b[r][i]); fb[2 * i + 1] = bfhi(b[r][i]); }
#pragma unroll
            for (int i = 0; i < 8; ++i) { sa += fa[i] * fa[i]; sb += fb[i] * fb[i]; }
            const float ra = 1.0f / sqrtf(wave_sum(sa) * (1.0f / QLR) + RMS_EPS), rb = 1.0f / sqrtf(wave_sum(sb) * (1.0f / KVLR) + RMS_EPS);
            if (m0 + r * NGW < MTOK) {
                if (lane < 48) { u32x4 w;
                    w.x = cvt_pk_bf16(fa[0] * ra * gq0.x, fa[1] * ra * gq0.y); w.y = cvt_pk_bf16(fa[2] * ra * gq0.z, fa[3] * ra * gq0.w); w.z = cvt_pk_bf16(fa[4] * ra * gq1.x, fa[5] * ra * gq1.y); w.w = cvt_pk_bf16(fa[6] * ra * gq1.z, fa[7] * ra * gq1.w);
                    *(u32x4*)(CQN + (size_t)m[r] * QLR + 8 * lane) = w; }
                if (lane < 32) { u32x4 w;
                    w.x = cvt_pk_bf16(fb[0] * rb * gk0.x, fb[1] * rb * gk0.y); w.y = cvt_pk_bf16(fb[2] * rb * gk0.z, fb[3] * rb * gk0.w); w.z = cvt_pk_bf16(fb[4] * rb * gk1.x, fb[5] * rb * gk1.y); w.w = cvt_pk_bf16(fb[6] * rb * gk1.z, fb[7] * rb * gk1.w);
                    *(u32x4*)(CKVN + (size_t)m[r] * KVLR + 8 * lane) = w; }
                if (lane < 16) { const float x1 = bf2f(k1[r]), x2 = bf2f(k2[r]); float c, s; rope_cs(m[r] & (SEQ - 1), lane, c, s);
                    KR[(size_t)m[r] * 32 + lane] = (bf16_t)(cvt_pk_bf16(x1 * c - x2 * s, 0.f) & 0xffffu); KR[(size_t)m[r] * 32 + 16 + lane] = (bf16_t)(cvt_pk_bf16(x1 * s + x2 * c, 0.f) & 0xffffu); }
            }
        }
    }
}
__device__ __forceinline__ void t_mla_prep2(const bf16_t* PROJ, const float* SSL, float* RSQ, float* RSKV, bf16_t* KR, int gw, int NGW, int lane) {
    asm volatile("" : "+v"(lane));
    constexpr int R = 8;
    for (int m0 = gw; m0 < MTOK; m0 += R * NGW) {
        unsigned short k1[R], k2[R]; f32x4 sa[R], sb[R], sc[R]; int m[R];
#pragma unroll
        for (int r = 0; r < R; ++r) { m[r] = min(m0 + r * NGW, MTOK - 1); const bf16_t* p = PROJ + (size_t)m[r] * PJ; k1[r] = 0; k2[r] = 0;
            if (lane < 16) { k1[r] = p[PC_KR + lane]; k2[r] = p[PC_KR + 16 + lane]; }
            const f32x4* sp = (const f32x4*)(SSL + (size_t)m[r] * 16); sa[r] = sp[0]; sb[r] = sp[1]; sc[r] = sp[2]; }
#pragma unroll
        for (int r = 0; r < R; ++r) {
            if (m0 + r * NGW < MTOK) {
                if (lane == 32) { const float sq = ((sa[r].x + sa[r].y) + (sa[r].z + sa[r].w)) + ((sb[r].x + sb[r].y) + (sb[r].z + sb[r].w)), skv = (sc[r].x + sc[r].y) + (sc[r].z + sc[r].w);
                    RSQ[m[r]] = 1.0f / sqrtf(sq * (1.0f / QLR) + RMS_EPS); RSKV[m[r]] = 1.0f / sqrtf(skv * (1.0f / KVLR) + RMS_EPS); }
                if (lane < 16) { const float x1 = bf2f(k1[r]), x2 = bf2f(k2[r]); float c, s_; rope_cs(m[r] & (SEQ - 1), lane, c, s_);
                    KR[(size_t)m[r] * 32 + lane] = (bf16_t)(cvt_pk_bf16(x1 * c - x2 * s_, 0.f) & 0xffffu); KR[(size_t)m[r] * 32 + 16 + lane] = (bf16_t)(cvt_pk_bf16(x1 * s_ + x2 * c, 0.f) & 0xffffu); }
            }
        }
    }
}
__device__ __forceinline__ void t_post_attn(const bf16_t* OA, const f32x2* ML, const bf16_t* YC, const float* ga, const float* gb, const float* gc, bf16_t* YN, int gw, int NGW, int lane) {
    asm volatile("" : "+v"(lane));
    constexpr int R = 4;
    const bool lo = lane < 32;
    f32x4 gg[4];
#pragma unroll
    for (int j = 0; j < 4; ++j) { const int c = 4 * lane + 256 * j; const float* gp = (c < 384) ? (ga + c) : ((c < 768) ? (gb + c - 384) : (gc + c - 768)); gg[j] = *(const f32x4*)gp; }
    for (int m0 = gw; m0 < MTOK; m0 += R * NGW) {
        int m[R]; f32x2 ml[R][3][3]; u32x2 oa[R][3][3]; u32x2 yv[R];
#pragma unroll
        for (int r = 0; r < R; ++r) { m[r] = min(m0 + r * NGW, MTOK - 1);
#pragma unroll
            for (int j = 0; j < 3; ++j) { const int c = 4 * lane + 256 * j; const bool isA = c < 384; const int cp = isA ? c : c - 384, pb = isA ? 0 : 3, h = cp >> 6;
#pragma unroll
                for (int g = 0; g < 3; ++g) { const int part = pb + ((isA || g < 2) ? g : 1);
                    ml[r][j][g] = ML[((size_t)part * MTOK + m[r]) * 8 + h]; oa[r][j][g] = *(const u32x2*)(OA + ((size_t)part * MTOK + m[r]) * 384 + cp); } }
            yv[r] = *(const u32x2*)(YC + (size_t)m[r] * 256 + 4 * lane); }
#pragma unroll
        for (int r = 0; r < R; ++r) {
            f32x4 v[4];
#pragma unroll
            for (int j = 0; j < 3; ++j) {
                const int c = 4 * lane + 256 * j; const bool isA = c < 384;
                const float mx = fmaxf(fmaxf(ml[r][j][0].x, ml[r][j][1].x), ml[r][j][2].x);
                float w[3]; float ws_ = 0.f;
#pragma unroll
                for (int g = 0; g < 3; ++g) { w[g] = (isA || g < 2) ? ml[r][j][g].y * __expf(ml[r][j][g].x - mx) : 0.f; ws_ += w[g]; }
                const float rw = 1.0f / ws_; f32x4 acc = {0.f, 0.f, 0.f, 0.f};
#pragma unroll
                for (int g = 0; g < 3; ++g) { const u32x2 t = oa[r][j][g]; const float wg = w[g] * rw;
                    acc.x += wg * bflo(t.x); acc.y += wg * bfhi(t.x); acc.z += wg * bflo(t.y); acc.w += wg * bfhi(t.y); }
                v[j] = acc;
            }
            { const u32x2 t = yv[r]; v[3] = (f32x4){bflo(t.x), bfhi(t.x), bflo(t.y), bfhi(t.y)}; }
            float ss[4];
#pragma unroll
            for (int j = 0; j < 4; ++j) ss[j] = (v[j].x * v[j].x + v[j].y * v[j].y) + (v[j].z * v[j].z + v[j].w * v[j].w);
            const float sA = wave_sum(ss[0] + (lo ? ss[1] : 0.f)), sB = wave_sum((lo ? 0.f : ss[1]) + ss[2]), sC = wave_sum(ss[3]);
            const float rA = 1.0f / sqrtf(sA * (1.0f / 384.f) + RMS_EPS), rB = 1.0f / sqrtf(sB * (1.0f / 384.f) + RMS_EPS), rC = 1.0f / sqrtf(sC * (1.0f / 256.f) + RMS_EPS);
            if (m0 + r * NGW < MTOK) {
                u32x2* o8 = (u32x2*)(YN + (size_t)m[r] * DM) + lane;
#pragma unroll
                for (int j = 0; j < 4; ++j) { const int c = 4 * lane + 256 * j;
                    const float rr = (c < 384) ? rA : ((c < 768) ? rB : rC);
                    u32x2 w; w.x = cvt_pk_bf16(v[j].x * rr * gg[j].x, v[j].y * rr * gg[j].y); w.y = cvt_pk_bf16(v[j].z * rr * gg[j].z, v[j].w * rr * gg[j].w); o8[64 * j] = w; }
            }
        }
    }
}
__device__ __forceinline__ void t_norm_route(const bf16_t* X, const float* gain, const float* wr, bf16_t* XN, int* BCNT  , i32x4* ASG, f32x2* GATE,
                                             LAS unsigned char* lds, int wave, int lane) {
    asm volatile("" : "+v"(lane));
    LAS int* cntL = (LAS int*)(lds + MISC_OFF + 320);
    f32x4 wq[4][4][2], gg[4];
#pragma unroll
    for (int j = 0; j < 4; ++j) { gg[j] = *((const f32x4*)gain + lane + 64 * j);
#pragma unroll
        for (int i = 0; i < 4; ++i) { const f32x4* wp = (const f32x4*)(wr + (size_t)(4 * lane + 256 * j + i) * 8); wq[j][i][0] = wp[0]; wq[j][i][1] = wp[1]; } }
    for (int batch = blockIdx.x; batch < MTOK / 64; batch += gridDim.x) {
        int my_e0 = 0, my_e1 = 0; float my_g0 = 0.f, my_g1 = 0.f;
#pragma unroll 1
        for (int rg = 0; rg < 2; ++rg) {
        f32x4 xv[4][4];
#pragma unroll
        for (int r4 = 0; r4 < 4; ++r4) { const u32x2* xr = (const u32x2*)(X + (size_t)(batch * 64 + wave * 8 + rg * 4 + r4) * DM) + lane;
#pragma unroll
            for (int j = 0; j < 4; ++j) { const u32x2 w = xr[64 * j]; xv[r4][j] = (f32x4){bflo(w.x), bfhi(w.x), bflo(w.y), bfhi(w.y)}; } }
#pragma unroll
        for (int r4 = 0; r4 < 4; ++r4) {
            const int rr = rg * 4 + r4;
            const int m = batch * 64 + wave * 8 + rr;
            f32x4 v[4];
#pragma unroll
            for (int j = 0; j < 4; ++j) v[j] = xv[r4][j];
            const float rstd = row_rstd(v);
            float lg[8];
#pragma unroll
            for (int e = 0; e < 8; ++e) lg[e] = 0.f;
            u32x2* o8 = (u32x2*)(XN + (size_t)m * DM) + lane;
#pragma unroll
            for (int j = 0; j < 4; ++j) {
                const f32x4 hh = {v[j].x * rstd * gg[j].x, v[j].y * rstd * gg[j].y, v[j].z * rstd * gg[j].z, v[j].w * rstd * gg[j].w};
                u32x2 w; w.x = cvt_pk_bf16(hh.x, hh.y); w.y = cvt_pk_bf16(hh.z, hh.w); o8[64 * j] = w;
#pragma unroll
                for (int i = 0; i < 4; ++i) { const f32x4 w0 = wq[j][i][0], w1 = wq[j][i][1]; const float hv = hh[i];
                    lg[0] += hv * w0.x; lg[1] += hv * w0.y; lg[2] += hv * w0.z; lg[3] += hv * w0.w; lg[4] += hv * w1.x; lg[5] += hv * w1.y; lg[6] += hv * w1.z; lg[7] += hv * w1.w; } }
#pragma unroll
            for (int e = 0; e < 8; ++e) lg[e] = wave_sum(lg[e]);
            int e0 = 0; float l0 = lg[0];
#pragma unroll
            for (int e = 1; e < 8; ++e) if (lg[e] > l0) { l0 = lg[e]; e0 = e; }
            int e1 = -1; float l1 = -3.0e38f;
#pragma unroll
            for (int e = 0; e < 8; ++e) if (e != e0 && lg[e] > l1) { l1 = lg[e]; e1 = e; }
            const float ex = __expf(l1 - l0); const float g0 = 1.0f / (1.0f + ex), g1 = ex * g0;
            if (lane == rr) { my_e0 = e0; my_e1 = e1; my_g0 = g0; my_g1 = g1; }
        }
        }
        const bool valid = lane < 8;
        if (lane < 8) { const int m = batch * 64 + wave * 8 + lane; ASG[m] = (i32x4){my_e0, 0, my_e1, 0}; GATE[m] = (f32x2){my_g0, my_g1}; }
        int c = 0;
#pragma unroll
        for (int e = 0; e < 8; ++e) { const int ce = __popcll(__ballot(valid && my_e0 == e)) + __popcll(__ballot(valid && my_e1 == e)); if (lane == e) c = ce; }
        if (lane < 8) cntL[wave * 8 + lane] = c;
        __syncthreads();
        if (wave == 0 && lane < 8) { int tot = 0;
#pragma unroll
            for (int w = 0; w < 8; ++w) tot += cntL[w * 8 + lane];
            BCNT[batch * 8 + lane] = tot; }
        __syncthreads();
    }
}
__device__ __forceinline__ void t_assign(const int* BCNT, int* TOK, i32x4* ASG, LAS int* cntm, LAS int* sbm, LAS unsigned char* lds, int wave, int lane) {
    LAS int* baseL = (LAS int*)(lds + MISC_OFF + 256);
    constexpr int NB64 = MTOK / 64;
    if (wave == 0) { int tot = 0;
        for (int i = 0; i < NB64 / 8; ++i) tot += BCNT[lane + 64 * i];
        tot += __shfl_xor(tot, 8); tot += __shfl_xor(tot, 16); tot += __shfl_xor(tot, 32);
        if (lane < 8) cntm[lane] = tot; }
    for (int batch = blockIdx.x; batch < NB64; batch += gridDim.x) {
        if (wave == 0) {
            { int base = 0; for (int i = 0; i < NB64 / 8; ++i) { const int v = BCNT[lane + 64 * i]; base += ((lane >> 3) + 8 * i < batch) ? v : 0; }
              base += __shfl_xor(base, 8); base += __shfl_xor(base, 16); base += __shfl_xor(base, 32);
              if (lane < 8) baseL[lane] = base; }
            asm volatile("s_waitcnt lgkmcnt(0)" ::: "memory");
            const int m = batch * 64 + lane; const i32x4 a = ASG[m];
            const unsigned long long lt = (1ull << lane) - 1ull, le = lt | (1ull << lane);
            int rank0 = 0, rank1 = 0;
#pragma unroll
            for (int e = 0; e < 8; ++e) { const unsigned long long m0 = __ballot(a.x == e), m1 = __ballot(a.z == e); const int bs = baseL[e];
                if (a.x == e) rank0 = bs + __popcll(m0 & lt) + __popcll(m1 & lt);
                if (a.z == e) rank1 = bs + __popcll(m0 & le) + __popcll(m1 & lt); }
            TOK[a.x * 16384 + rank0] = m; TOK[a.z * 16384 + rank1] = m;
            ASG[m] = (i32x4){a.x, rank0, a.z, rank1};
        }
    }
    __syncthreads();
    if (threadIdx.x == 0) { int s = 0; for (int e = 0; e < 8; ++e) { sbm[e] = s; s += (cntm[e] + 255) >> 8; } }
    __syncthreads();
}


struct Args { const float* in[21]; float* out; unsigned char* ws; int nsub; int pad; };
#define PH_BEGIN() kptr_t kp_ = kp; GAS unsigned char* ws_ = (GAS unsigned char*)ws; asm volatile("" : "+s"(kp_), "+s"(ws_))
#define INP(i) ((const float*)(*(GAS const float* const __attribute__((address_space(4)))*)(kp_ + 8 * (i))))
#define WSP(T, off) ((T*)(GAS T*)(ws_ + (off)))
enum { I_X = 0, I_GMIX, I_WIN, I_GQ, I_GKV, I_WUQ, I_WUKV, I_RPB, I_GOA, I_GOB, I_GOC, I_WO, I_GFFN, I_W1, I_W3, I_W2, I_WR, I_EW1, I_EW3, I_EW2, I_GFIN };
#define TID ((int)threadIdx.x)
#define LANE ((int)threadIdx.x & 63)
#define GRID_BAR() xcd_barrier(bar)
template <int l> __device__ __forceinline__ void run_layer(const kptr_t kp, unsigned char* const ws, LAS unsigned char* const lds, const XcdBarrier& bar, const int G, const int bx, const int vcu, const int wave, const int nsub) {
    const int gw = vcu * 8 + wave, NGW = G * 8;
    LAS int* sbm = (LAS int*)(lds + MISC_OFF + 64);
    LAS int* cntm = (LAS int*)(lds + MISC_OFF + 96);
    if constexpr (l == 1 || l == 3) { PH_BEGIN(); t_rs(WSP(float, WS_XN)  , WSP(float, WS_RSTD), bx, G, TID); }
    else { PH_BEGIN(); bf16_t* X = WSP(bf16_t, WS_X); const bool pending = (l == 2);
      t_norm<(l == 2) ? 2 : 4, (l != 0)>(l == 0 ? (const void*)INP(I_X) : (const void*)X, (pending || l == 0) ? X : nullptr, WSP(float, WS_RSTD), gw, NGW, LANE, pending, WSP(i32x4, WS_ASG), WSP(f32x2, WS_GATE), WSP(float, WS_YB), sbm); }
    GRID_BAR();
    { PH_BEGIN(); pg8::Gemm g{WSP(bf16_t, WS_X), WSP(bf16_t, WS_WIN) + (size_t)l * PJ * DM, DM, nullptr, 0}; pg8::StaticOrder S; S.init(MTOK, PJ, G, bx);
      pg8::EpiBf16S E{WSP(bf16_t, WS_PROJ), PJ, WSP(float, WS_RSTD), WSP(float, WS_XN + 2 * MiB)  };
      pg8::gemm_phase<pg8::EpiBf16S, pg8::StaticOrder, true, false>(lds + RING_OFF, g, S, E); }
    GRID_BAR();
    { PH_BEGIN(); t_mla_prep2(WSP(bf16_t, WS_PROJ), WSP(float, WS_XN + 2 * MiB), WSP(float, WS_RSQ), WSP(float, WS_RSKV), WSP(bf16_t, WS_KR), gw, NGW, LANE); }
    GRID_BAR();
    { PH_BEGIN(); pg8::Gemm g{WSP(bf16_t, WS_PROJ) + PC_CQ, WSP(bf16_t, WS_WUQ) + (size_t)l * QUP_PAD * QLR, QLR, nullptr, PJ}; pg8::StaticOrder S; S.init(MTOK, QUP_PAD, G, bx);
      pg8::EpiBf16S E{WSP(bf16_t, WS_QB), QUP_PAD, WSP(float, WS_RSQ), nullptr};
      pg8::gemm_phase<pg8::EpiBf16S, pg8::StaticOrder, true, false, false, true>(lds + RING_OFF, g, S, E); }
    { PH_BEGIN(); pg8::Gemm g{WSP(bf16_t, WS_PROJ) + PC_CKV, WSP(bf16_t, WS_WUKV) + (size_t)l * KVUP * KVLR, KVLR, nullptr, PJ}; pg8::StaticOrder S; S.init(MTOK, KVUP, G, (bx + G / 2) % G);
      pg8::EpiBf16S E{WSP(bf16_t, WS_KVB), KVUP, WSP(float, WS_RSKV), nullptr};
      pg8::gemm_phase<pg8::EpiBf16S, pg8::StaticOrder, true, false, false, true>(lds + RING_OFF, g, S, E); }
    GRID_BAR();
    {
        LAS char* al = (LAS char*)(lds + RING_OFF);
        const int ub0 = (vcu * 768) / G, nb = ((vcu + 1) * 768) / G - ub0, ua0 = (vcu * 1152) / G, na = ((vcu + 1) * 1152) / G - ua0, uc0 = (vcu * 256) / G, nc = ((vcu + 1) * 256) / G - uc0;
#pragma unroll 1
        for (int k = 0; k < nb; ++k) { PH_BEGIN(); const int ub = ub0 + k, grp = ub >> 5, bh = grp >> 1; att::mla_unit(bh / 6, bh % 6, ub & 31, grp & 1, WSP(bf16_t, WS_QB), WSP(bf16_t, WS_KVB), WSP(bf16_t, WS_KR), WSP(bf16_t, WS_OA), WSP(f32x2, WS_ML), al); }
        { PH_BEGIN(); att::dil_phase(ua0, na, WSP(bf16_t, WS_PROJ), WSP(bf16_t, WS_OA), WSP(f32x2, WS_ML), al); }
        { PH_BEGIN(); att::nat_phase(uc0, nc, WSP(bf16_t, WS_PROJ), WSP(bf16_t, WS_Y), INP(I_RPB) + (size_t)l * 4 * 465, al); }
    }
    GRID_BAR();
    { PH_BEGIN(); t_post_attn(WSP(bf16_t, WS_OA), WSP(f32x2, WS_ML), WSP(bf16_t, WS_Y), INP(I_GOA) + l * 384, INP(I_GOB) + l * 384, INP(I_GOC) + l * 256, WSP(bf16_t, WS_YN), gw, NGW, LANE); }
    GRID_BAR();
    { PH_BEGIN(); pg8::Gemm g{WSP(bf16_t, WS_YN), WSP(bf16_t, WS_WO) + (size_t)l * DM * DM, DM, nullptr, 0}; pg8::StaticOrder S; S.init(MTOK, DM, G, bx);
      pg8::EpiResidB E{nullptr, WSP(bf16_t, WS_X), WSP(bf16_t, WS_X), DM, (l & 1) ? nullptr : WSP(float, WS_XN)};
      pg8::gemm_phase<pg8::EpiResidB, pg8::StaticOrder, true, false>(lds + RING_OFF, g, S, E); }
    GRID_BAR();
    if (2 * l + 1 >= nsub) return;
    const int j = l >> 1;
    if constexpr ((l & 1) == 0) {
        { PH_BEGIN(); t_rs(WSP(float, WS_XN), WSP(float, WS_RSTD), bx, G, TID); }
        GRID_BAR();
        { PH_BEGIN(); pg8::Gemm g{WSP(bf16_t, WS_X), WSP(bf16_t, WS_W13) + (size_t)j * 2 * DFF * DM, DM, nullptr, 0}; pg8::StaticOrder S; S.init(MTOK, 2 * DFF, G, bx);
          pg8::EpiSwiGLUS E{WSP(bf16_t, WS_H), DFF, WSP(float, WS_RSTD)};
          pg8::gemm_phase<pg8::EpiSwiGLUS, pg8::StaticOrder, true, false>(lds + RING_OFF, g, S, E); }
        GRID_BAR();
        { PH_BEGIN(); pg8::Gemm g{WSP(bf16_t, WS_H), WSP(bf16_t, WS_W2) + (size_t)j * DM * DFF, DFF, nullptr, 0}; pg8::StaticOrder S; S.init(MTOK, DM, G, bx);
          pg8::EpiResidB E{nullptr, WSP(bf16_t, WS_X), WSP(bf16_t, WS_X), DM, WSP(float, WS_XN)};
          pg8::gemm_phase<pg8::EpiResidB, pg8::StaticOrder, true, false>(lds + RING_OFF, g, S, E); }
        GRID_BAR();
    } else {
        { PH_BEGIN(); t_norm_route(WSP(bf16_t, WS_X), INP(I_GFFN) + l * DM, INP(I_WR) + (size_t)j * DM * 8, WSP(bf16_t, WS_XN), WSP(int, WS_CTL) + CW_CUR + j * 2048, WSP(i32x4, WS_ASG), WSP(f32x2, WS_GATE), lds, wave, LANE); }
        GRID_BAR();
        { PH_BEGIN(); t_assign(WSP(int, WS_CTL) + CW_CUR + j * 2048, WSP(int, WS_TOK) + (size_t)j * 8 * 16384, WSP(i32x4, WS_ASG), cntm, sbm, lds, wave, LANE); }
        GRID_BAR();
        const int NBm = sbm[7] + ((cntm[7] + 255) >> 8);
        { PH_BEGIN(); pg8::Gemm g{WSP(bf16_t, WS_XN), WSP(bf16_t, WS_EW13) + (size_t)j * 8 * 2 * DFFE * DM, DM, WSP(int, WS_TOK) + (size_t)j * 8 * 16384, 0}; pg8::MoeOrder S; S.init(cntm, 2 * DFFE, G, bx);
          pg8::EpiSwiGLU E{WSP(bf16_t, WS_H), DFFE};
          pg8::gemm_phase<pg8::EpiSwiGLU, pg8::MoeOrder, true, true>(lds + RING_OFF, g, S, E); }
        GRID_BAR();
        int pm0 = (((4 * NBm) % G) + 3) >> 2; if (pm0 > 8) pm0 = 0;
        if (TID == 0) sbm[16] = pm0 * 256;
        { PH_BEGIN(); pg8::Gemm g{WSP(bf16_t, WS_H), WSP(bf16_t, WS_EW2) + (size_t)j * 8 * DM * DFFE, DFFE, nullptr, 0}; pg8::MoeOrder S; S.init(cntm, DM, G, bx); S.skip_rows(pm0);
          pg8::EpiBf16 E{WSP(bf16_t, WS_YB), DM};
          pg8::gemm_phase<pg8::EpiBf16, pg8::MoeOrder, true, false>(lds + RING_OFF, g, S, E); }
        if (pm0 > 0) { PH_BEGIN(); pg8::Gemm g{WSP(bf16_t, WS_H), WSP(bf16_t, WS_EW2) + (size_t)j * 8 * DM * DFFE, DFFE / 4, nullptr, DFFE}; pg8::MoeTailOrder S; S.init(cntm, DM, G, bx, pm0);
          pg8::EpiQuarter E{WSP(bf16_t, WS_YB), WSP(bf16_t, WS_YP), (size_t)2048 * DM, DM};
          pg8::gemm_phase<pg8::EpiQuarter, pg8::MoeTailOrder, true, false, true>(lds + RING_OFF, g, S, E); }
        GRID_BAR();
    }
}
__global__ void __launch_bounds__(512, 2) mega_fwd(Args args) {
    extern __shared__ __attribute__((aligned(16))) unsigned char lds_[];
    LAS unsigned char* lds = (LAS unsigned char*)lds_;
    volatile LAS unsigned* MISC = (volatile LAS unsigned*)(lds + MISC_OFF);
    const int wave = __builtin_amdgcn_readfirstlane((int)threadIdx.x >> 6);
    const int G = gridDim.x, bx = blockIdx.x, vcu = (G % 8 == 0) ? (bx % 8) * (G / 8) + bx / 8 : bx;
    const int gw = vcu * 8 + wave, NGW = G * 8;
    const kptr_t kp = (kptr_t)__builtin_amdgcn_kernarg_segment_ptr();
    unsigned char* const ws = *(unsigned char* const __attribute__((address_space(4)))*)(kp + 176);
    const int nsub = *(const int __attribute__((address_space(4)))*)(kp + 184);
    LAS int* sbm = (LAS int*)(lds + MISC_OFF + 64);

    for (int u = TID; u < 192; u += 512) ((LAS unsigned*)(lds + MISC_OFF))[u] = 0u;
    __syncthreads();
    XcdBarrier bar = xcd_barrier_post((unsigned*)(ws + WS_CTL) + CW_BAR, MISC + 8);

    { PH_BEGIN(); p_prologue(kp_, ws_, lds, gw, NGW, wave, LANE, bx * 512 + TID, G * 512); }
    GRID_BAR();

    if (nsub > 0) run_layer<0>(kp, ws, lds, bar, G, bx, vcu, wave, nsub);
    if (nsub > 2) run_layer<1>(kp, ws, lds, bar, G, bx, vcu, wave, nsub);
    if (nsub > 4) run_layer<2>(kp, ws, lds, bar, G, bx, vcu, wave, nsub);
    if (nsub > 6) run_layer<3>(kp, ws, lds, bar, G, bx, vcu, wave, nsub);
    { PH_BEGIN(); float* out = (float*)(*(GAS float* const __attribute__((address_space(4)))*)(kp_ + 168));
      const bool pending = (nsub == 4 || nsub == 8);
      if (nsub == 0) t_final<false>(INP(I_X), out, INP(I_GFIN), gw, NGW, LANE, pending, WSP(i32x4, WS_ASG), WSP(f32x2, WS_GATE), WSP(float, WS_YB), sbm);
      else t_final<true>(WSP(bf16_t, WS_X), out, INP(I_GFIN), gw, NGW, LANE, pending, WSP(i32x4, WS_ASG), WSP(f32x2, WS_GATE), WSP(float, WS_YB), sbm); }
}

extern "C" void kernel_launch(void* const* d_in, const int* in_sizes, int n_in, void* d_out, int out_size, void* d_ws, size_t ws_size, hipStream_t stream) {
    static int grid = 0;
    if (grid == 0) {
        if (n_in != 21 || in_sizes[0] != MTOK * DM || out_size != MTOK * DM || ws_size < WS_END) {
            fprintf(stderr, "kernel_launch: built for 21 inputs, x/out of %d floats, >= %zu bytes of workspace; got n_in %d, in0 %d, out %d, ws %zu; nothing launched\n", MTOK * DM, (size_t)WS_END, n_in, n_in > 0 ? in_sizes[0] : -1, out_size, ws_size); grid = -1; return; }
        int dev = 0, cus = 0, per_cu = 0;
        if (hipGetDevice(&dev) != hipSuccess || hipDeviceGetAttribute(&cus, hipDeviceAttributeMultiprocessorCount, dev) != hipSuccess) { fprintf(stderr, "kernel_launch: device query failed\n"); grid = -1; return; }
        if (hipFuncSetAttribute((const void*)mega_fwd, hipFuncAttributeMaxDynamicSharedMemorySize, LDS_BYTES) != hipSuccess) { fprintf(stderr, "kernel_launch: hipFuncSetAttribute failed\n"); grid = -1; return; }
        if (hipOccupancyMaxActiveBlocksPerMultiprocessor(&per_cu, (const void*)mega_fwd, 512, LDS_BYTES) != hipSuccess || per_cu < 1)
            fprintf(stderr, "kernel_launch: note: occupancy query reports %d workgroups per CU\n", per_cu);
        (void)hipGetLastError();
        grid = cus;
    }
    if (grid < 0) return;
    if (hipMemsetAsync((char*)d_ws + WS_CTL, 0, CTL_ZERO_BYTES, stream) != hipSuccess) { fprintf(stderr, "kernel_launch: memset failed\n"); return; }
    Args a{};
    for (int i = 0; i < 21; ++i) a.in[i] = (const float*)d_in[i];
    a.out = (float*)d_out; a.ws = (unsigned char*)d_ws; a.nsub = DBG_NSUB; a.pad = 0;
    hipLaunchKernelGGL(mega_fwd, dim3(grid), dim3(512), LDS_BYTES, stream, a);
    const hipError_t le = hipPeekAtLastError();
    if (le != hipSuccess) fprintf(stderr, "kernel_launch: launch failed: %s\n", hipGetErrorName(le));
}
```
